# Optimizing an MI355X kernel written in HIP

```python
import jax, jax.numpy as jnp
from jax import lax
import numpy as np

D_MODEL = 1024
BATCH = 2
SEQ = 8192
DEPTH = 2

D_FF = 2816
N_HEADS = 16
N_KV_GROUPS = 2
HEADS_PER_GROUP = N_HEADS // N_KV_GROUPS
HEAD_DIM = 64
CMP_LEN = 32
CMP_STRIDE = 16
CMP_HIDDEN = 256
SEL_LEN = 64
N_SELECT = 16
WINDOW = 512
Q_BLOCK = 128
POOL_WINDOWS = (2, 4, 8, 16)
POOL_GROUP_DIM = 128
POOL_WIDTH = len(POOL_WINDOWS) * POOL_GROUP_DIM
N_BRANCHES = 2
Q_WIDTH = N_HEADS * HEAD_DIM
KV_WIDTH = N_KV_GROUPS * HEAD_DIM
N_NSA_GATES = 3 * N_HEADS
IN_SPLITS = (Q_WIDTH, KV_WIDTH, KV_WIDTH, KV_WIDTH, KV_WIDTH, KV_WIDTH, KV_WIDTH,
             N_NSA_GATES, POOL_WIDTH, N_BRANCHES * D_MODEL)
IN_WIDTH = sum(IN_SPLITS)
RMS_EPS = 1e-6
ALIBI_MAX_BIAS = 8.0

kernel_name = "hybrid_pool_nsa_macaron_gated"


def rmsnorm(x, g):
    xf = x.astype(jnp.float32)
    y = xf * lax.rsqrt(jnp.mean(xf * xf, axis=-1, keepdims=True) + RMS_EPS)
    return (y * g.astype(jnp.float32)).astype(x.dtype)


def swiglu(x, w_gate, w_up, w_down):
    return (jax.nn.silu(x @ w_gate) * (x @ w_up)) @ w_down


def masked_softmax(s, mask):
    s = jnp.where(mask, s.astype(jnp.float32), -1e30)
    s = s - jnp.max(s, axis=-1, keepdims=True)
    p = jnp.where(mask, jnp.exp(s), 0.0)
    return p / jnp.maximum(jnp.sum(p, axis=-1, keepdims=True), 1e-30)


def alibi_slopes():
    h = jnp.arange(1, N_HEADS + 1, dtype=jnp.float32)
    m = jnp.exp2(-ALIBI_MAX_BIAS * h / N_HEADS)
    return m.reshape(N_KV_GROUPS, HEADS_PER_GROUP)


def multiscale_pool(u, w_group, scale):
    B, T, _ = u.shape
    n_g = len(POOL_WINDOWS)
    uf = u.astype(jnp.float32)
    cs = jnp.cumsum(uf, axis=1)
    pos = jnp.arange(T, dtype=jnp.float32)
    outs = []
    for gi, w in enumerate(POOL_WINDOWS):
        c = cs[..., gi * POOL_GROUP_DIM:(gi + 1) * POOL_GROUP_DIM]
        lag = jnp.pad(c, ((0, 0), (w, 0), (0, 0)))[:, :T]
        cnt = jnp.minimum(pos + 1.0, float(w))[None, :, None]
        outs.append((c - lag) / cnt)
    pooled = jnp.stack(outs, axis=2)
    delta = (pooled - uf.reshape(B, T, n_g, POOL_GROUP_DIM)).astype(u.dtype)
    mixed = jnp.einsum('btgc,gcd->btgd', delta, w_group).reshape(B, T, POOL_WIDTH)
    return mixed * scale


def compress_tokens(kv, pos_emb, w1, w2):
    B, T = kv.shape[:2]
    n_cmp = (T - CMP_LEN) // CMP_STRIDE + 1
    idx = jnp.arange(n_cmp)[:, None] * CMP_STRIDE + jnp.arange(CMP_LEN)[None, :]
    blocks = kv[:, idx] + pos_emb[None, None, :, None, :]
    blocks = blocks.transpose(0, 1, 3, 2, 4).reshape(B, n_cmp, N_KV_GROUPS, CMP_LEN * HEAD_DIM)
    return jax.nn.gelu(blocks @ w1) @ w2


def cmp_to_sel_overlap(T):
    n_cmp = (T - CMP_LEN) // CMP_STRIDE + 1
    n_sel = T // SEL_LEN
    cs = np.arange(n_cmp)[:, None] * CMP_STRIDE
    ss = np.arange(n_sel)[None, :] * SEL_LEN
    ov = np.clip(np.minimum(cs + CMP_LEN, ss + SEL_LEN) - np.maximum(cs, ss), 0, None) / CMP_LEN
    return jnp.asarray(ov, dtype=jnp.float32)


def nsa_attention(q, k_cmp, v_cmp, k_slc, v_slc, k_win, v_win, gates):
    B, T = q.shape[:2]
    n_cmp = k_cmp.shape[1]
    n_sel = T // SEL_LEN
    n_top = min(N_SELECT, n_sel)
    slopes = alibi_slopes()[None, :, :, None, None]
    overlap = cmp_to_sel_overlap(T)
    cmp_end = jnp.arange(n_cmp) * CMP_STRIDE + CMP_LEN - 1
    kb = k_slc.reshape(B, n_sel, SEL_LEN, N_KV_GROUPS, HEAD_DIM).transpose(0, 3, 1, 2, 4)
    vb = v_slc.reshape(B, n_sel, SEL_LEN, N_KV_GROUPS, HEAD_DIM).transpose(0, 3, 1, 2, 4)
    kw_pad = jnp.pad(k_win, ((0, 0), (WINDOW, 0), (0, 0), (0, 0)))
    vw_pad = jnp.pad(v_win, ((0, 0), (WINDOW, 0), (0, 0), (0, 0)))
    gather = jax.vmap(jax.vmap(lambda blk, ix: blk[ix]))
    sel_ids = jnp.arange(n_sel)
    n_sel_keys = n_top * SEL_LEN

    def query_block(c):
        q0 = c * Q_BLOCK
        t = q0 + jnp.arange(Q_BLOCK)
        qc = lax.dynamic_slice_in_dim(q, q0, Q_BLOCK, axis=1)
        gc = lax.dynamic_slice_in_dim(gates, q0, Q_BLOCK, axis=1)

        dist_c = (t[:, None] - cmp_end[None, :]).astype(jnp.float32)
        s = jnp.einsum('bqghd,bngd->bghqn', qc, k_cmp) - slopes * dist_c
        p_cmp = masked_softmax(s, dist_c >= 0)
        o_cmp = jnp.einsum('bghqn,bngd->bqghd', p_cmp.astype(v_cmp.dtype), v_cmp)

        score = jnp.einsum('bghqn,nj->bgqj', p_cmp, overlap)
        cur = t // SEL_LEN
        valid = sel_ids[None, :] * SEL_LEN <= t[:, None]
        forced = valid & ((sel_ids[None, :] == 0) | (sel_ids[None, :] == cur[:, None])
                          | (sel_ids[None, :] == cur[:, None] - 1))
        score = jnp.where(forced, jnp.inf, jnp.where(valid, score, -jnp.inf))
        _, idx = lax.top_k(score, n_top)
        ks = gather(kb, idx).reshape(B, N_KV_GROUPS, Q_BLOCK, n_sel_keys, HEAD_DIM)
        vs = gather(vb, idx).reshape(B, N_KV_GROUPS, Q_BLOCK, n_sel_keys, HEAD_DIM)
        kpos = (idx[..., None] * SEL_LEN + jnp.arange(SEL_LEN)).reshape(B, N_KV_GROUPS, Q_BLOCK, n_sel_keys)
        dist_s = (t[None, None, :, None] - kpos)[:, :, None]
        s = jnp.einsum('bqghd,bgqkd->bghqk', qc, ks) - slopes * dist_s.astype(jnp.float32)
        p = masked_softmax(s, dist_s >= 0)
        o_slc = jnp.einsum('bghqk,bgqkd->bqghd', p.astype(vs.dtype), vs)

        kw = lax.dynamic_slice_in_dim(kw_pad, q0, WINDOW + Q_BLOCK, axis=1)
        vw = lax.dynamic_slice_in_dim(vw_pad, q0, WINDOW + Q_BLOCK, axis=1)
        wpos = q0 - WINDOW + jnp.arange(WINDOW + Q_BLOCK)
        dist_w = t[:, None] - wpos[None, :]
        mask_w = (dist_w >= 0) & (dist_w < WINDOW) & (wpos[None, :] >= 0)
        s = jnp.einsum('bqghd,bkgd->bghqk', qc, kw) - slopes * dist_w.astype(jnp.float32)
        p = masked_softmax(s, mask_w)
        o_win = jnp.einsum('bghqk,bkgd->bqghd', p.astype(vw.dtype), vw)

        return gc[..., 0:1] * o_cmp + gc[..., 1:2] * o_slc + gc[..., 2:3] * o_win

    out = lax.map(query_block, jnp.arange(T // Q_BLOCK))
    return out.transpose(1, 0, 2, 3, 4, 5).reshape(B, T, N_HEADS * HEAD_DIM)


def setup_inputs(seed: int = 0) -> dict:
    key = jax.random.key(seed)
    ks = jax.random.split(key, 24)

    def dense(k, shape, fan_in):
        return jax.random.normal(k, shape, jnp.float32) * (fan_in ** -0.5)

    def gain(k, shape):
        return 1.0 + 0.01 * jax.random.normal(k, shape, jnp.float32)

    L = DEPTH
    return {
        "x": jax.random.normal(ks[0], (BATCH, SEQ, D_MODEL), jnp.float32),
        "ffn1_norm": gain(ks[1], (L, D_MODEL)),
        "ffn1_w_gate": dense(ks[2], (L, D_MODEL, D_FF), D_MODEL),
        "ffn1_w_up": dense(ks[3], (L, D_MODEL, D_FF), D_MODEL),
        "ffn1_w_down": dense(ks[4], (L, D_FF, D_MODEL), D_FF),
        "mix_norm": gain(ks[5], (L, D_MODEL)),
        "w_in": dense(ks[6], (L, D_MODEL, IN_WIDTH), D_MODEL),
        "cmp_pos": 0.1 * jax.random.normal(ks[7], (L, CMP_LEN, HEAD_DIM), jnp.float32),
        "cmp_k_w1": dense(ks[8], (L, CMP_LEN * HEAD_DIM, CMP_HIDDEN), CMP_LEN * HEAD_DIM),
        "cmp_k_w2": dense(ks[9], (L, CMP_HIDDEN, HEAD_DIM), CMP_HIDDEN),
        "cmp_v_w1": dense(ks[10], (L, CMP_LEN * HEAD_DIM, CMP_HIDDEN), CMP_LEN * HEAD_DIM),
        "cmp_v_w2": dense(ks[11], (L, CMP_HIDDEN, HEAD_DIM), CMP_HIDDEN),
        "pool_w": dense(ks[12], (L, len(POOL_WINDOWS), POOL_GROUP_DIM, POOL_GROUP_DIM), POOL_GROUP_DIM),
        "pool_scale": 1.0 + 0.1 * jax.random.normal(ks[13], (L, POOL_WIDTH), jnp.float32),
        "w_branch_pool": dense(ks[14], (L, POOL_WIDTH, D_MODEL), POOL_WIDTH),
        "w_branch_nsa": dense(ks[15], (L, Q_WIDTH, D_MODEL), Q_WIDTH),
        "w_out": dense(ks[16], (L, D_MODEL, D_MODEL), D_MODEL),
        "ffn2_norm": gain(ks[17], (L, D_MODEL)),
        "ffn2_w_gate": dense(ks[18], (L, D_MODEL, D_FF), D_MODEL),
        "ffn2_w_up": dense(ks[19], (L, D_MODEL, D_FF), D_MODEL),
        "ffn2_w_down": dense(ks[20], (L, D_FF, D_MODEL), D_FF),
        "final_norm": gain(ks[21], (D_MODEL,)),
    }


def reference(x, ffn1_norm, ffn1_w_gate, ffn1_w_up, ffn1_w_down, mix_norm, w_in, cmp_pos,
              cmp_k_w1, cmp_k_w2, cmp_v_w1, cmp_v_w2, pool_w, pool_scale, w_branch_pool,
              w_branch_nsa, w_out, ffn2_norm, ffn2_w_gate, ffn2_w_up, ffn2_w_down, final_norm):
    B, T, _ = x.shape
    split_points = list(np.cumsum(IN_SPLITS)[:-1])
    q_scale = HEAD_DIM ** -0.5
    for l in range(DEPTH):
        x = x + 0.5 * swiglu(rmsnorm(x, ffn1_norm[l]), ffn1_w_gate[l], ffn1_w_up[l], ffn1_w_down[l])

        h = rmsnorm(x, mix_norm[l])
        proj = h @ w_in[l]
        (q, kc, vc, ksl, vsl, kwn, vwn, g_nsa, u_pool, g_merge) = jnp.split(proj, split_points, axis=-1)
        kv_shape = (B, T, N_KV_GROUPS, HEAD_DIM)
        q = (q * q_scale).reshape(B, T, N_KV_GROUPS, HEADS_PER_GROUP, HEAD_DIM)
        k_cmp = compress_tokens(kc.reshape(kv_shape), cmp_pos[l], cmp_k_w1[l], cmp_k_w2[l])
        v_cmp = compress_tokens(vc.reshape(kv_shape), cmp_pos[l], cmp_v_w1[l], cmp_v_w2[l])
        nsa_gates = jax.nn.sigmoid(g_nsa).reshape(B, T, N_KV_GROUPS, HEADS_PER_GROUP, 3)
        o_nsa = nsa_attention(q, k_cmp, v_cmp, ksl.reshape(kv_shape), vsl.reshape(kv_shape),
                              kwn.reshape(kv_shape), vwn.reshape(kv_shape), nsa_gates)
        o_pool = multiscale_pool(u_pool, pool_w[l], pool_scale[l])

        g_pool, g_attn = jnp.split(jax.nn.sigmoid(g_merge), 2, axis=-1)
        merged = g_pool * (o_pool @ w_branch_pool[l]) + g_attn * (o_nsa @ w_branch_nsa[l])
        x = x + merged @ w_out[l]

        x = x + 0.5 * swiglu(rmsnorm(x, ffn2_norm[l]), ffn2_w_gate[l], ffn2_w_up[l], ffn2_w_down[l])
    return rmsnorm(x, final_norm)
```

```cpp
#include <hip/hip_runtime.h>
#include <hip/hip_cooperative_groups.h>
#include <cstdio>
#include <cstdint>
namespace cg = cooperative_groups;
typedef float f32x4_z __attribute__((ext_vector_type(4)));
__device__ __forceinline__ f32x4_z zero4() { float z = 0.f; asm volatile("" : "+v"(z)); return (f32x4_z){z, z, z, z}; }
namespace pg8 {
#define PG8_LAS __attribute__((address_space(3)))
typedef unsigned short bf16_t;
typedef short bf16x8 __attribute__((ext_vector_type(8)));
typedef float f32x4 __attribute__((ext_vector_type(4)));
typedef unsigned u32x4 __attribute__((ext_vector_type(4)));
constexpr int BM = 256, BK = 64, HALF = 128, HTB = HALF * BK * 2  , STAGE_BYTES = 8 * HTB, NXCD = 8, WGM = 8;

__host__ __device__ __forceinline__ int lds_byte(int r, int c) { const int st = (r >> 4) * 2 + (c >> 5), rr = r & 15, cc = c & 31, ob = rr * 64 + cc * 2; return st * 1024 + (ob ^ (((ob >> 9) & 1) << 5)); }
__host__ __device__ __forceinline__ void stage_rc(int b, int& R, int& C) { const int st = b / 1024, sb = b % 1024, swz = sb ^ (((sb >> 9) & 1) << 5); R = (st >> 1) * 16 + swz / 64; C = (st & 1) * 32 + (swz % 64) / 2; }
__host__ __device__ __forceinline__ int perm32(int rho) { const int n = rho >> 4, i = rho & 15; return 8 * (i >> 2) + 4 * n + (i & 3); }

struct Unit { int pm, pn; long ka, kb; };
struct Gemm { const bf16_t* A; const bf16_t* Bt; int M, N, K, lda, ldb; };

struct StaticOrder {
    int nM, nN, nwg, G, c;
    __host__ __device__ void init(int M, int N, int G_, int c_) { nM = M / BM; nN = N / BM; nwg = nM * nN; G = G_; c = c_; }
    __host__ __device__ bool next(int i, Unit& u) const {
        const long L = (long)i * G + c; if (L >= nwg) return false;
        int wgid = (int)L; { const int q = nwg / NXCD, r = nwg % NXCD, xcd = wgid % NXCD, off = wgid / NXCD; wgid = (xcd < r ? xcd * (q + 1) : r * (q + 1) + (xcd - r) * q) + off; }
        const int nig = WGM * nN, gid = wgid / nig, fm = gid * WGM, gsz = (nM - fm) < WGM ? (nM - fm) : WGM;
        u.pm = fm + ((wgid % nig) % gsz); u.pn = (wgid % nig) / gsz; u.ka = 0; u.kb = 0; return true;
    }
    __device__ __forceinline__ void a_ready(const Unit&) const {}
    __device__ __forceinline__ void done(const Unit&) const {}
};
__device__ __forceinline__ unsigned cvt_pk_bf16(float lo, float hi) { unsigned r; asm volatile("v_cvt_pk_bf16_f32 %0, %1, %2" : "=v"(r) : "v"(lo), "v"(hi)); return r; }
template <class Epi, class Sched, bool ALIGN_EPI = false, bool SP2 = false>
__device__ __forceinline__ void gemm_phase(PG8_LAS unsigned char* lds, const Gemm g, const Sched& S, const Epi& E, int tid_in) {
    int tid_ = tid_in; asm volatile("" : "+v"(tid_));
    const int tid = tid_, wid = __builtin_amdgcn_readfirstlane(tid >> 6), lane = tid & 63, wr = wid >> 2, wc = wid & 3, fr = lane & 15, fq = lane >> 4;
    const int K = g.K, nt = K / BK;
    unsigned voffA[2], voffB[2];
#pragma unroll
    for (int i = 0; i < 2; ++i) { int R, C; stage_rc(tid * 16 + i * 8192, R, C); const int Rb = Epi::PERM ? ((R & ~31) + perm32(R & 31)) : R;
        voffA[i] = (unsigned)(R * g.lda + C) * 2u; voffB[i] = (unsigned)(Rb * g.ldb + C) * 2u; }
    const size_t kstep = (size_t)(BK * 2);
    const size_t hstepA = (size_t)HALF * g.lda * 2, hstepB = (size_t)HALF * g.ldb * 2;
    const size_t tstepA = 2 * hstepA, tstepB = 2 * hstepB;
    const unsigned ldsw = (unsigned)wid * 1024u;
    const int aoff = lds_byte(wr * 64 + fr, fq * 8), boff = lds_byte(wc * 32 + fr, fq * 8);
#define PG8_SA(b, h) (((b) * 2 + (h)) * HTB)
#define PG8_SB(b, h) ((4 + (b) * 2 + (h)) * HTB)
#define PG8_STAGE(bufoff, gbase, voff) do { _Pragma("unroll") for (int _i = 0; _i < 2; ++_i) { unsigned _v = (voff)[_i]; asm volatile("" : "+v"(_v)); \
        __builtin_amdgcn_global_load_lds((const unsigned*)((const char*)(gbase) + _v), (PG8_LAS unsigned*)(lds + (bufoff) + ldsw + _i * 8192), 16, 0, 0); } } while (0)
#define PG8_LDA(dst, b, h) do { _Pragma("unroll") for (int m = 0; m < 4; ++m) _Pragma("unroll") for (int k = 0; k < 2; ++k) dst[m][k] = *(const PG8_LAS bf16x8*)(lds + PG8_SA(b, h) + aoff + m * 2048 + k * 1024); } while (0)
#define PG8_LDB(dst, b, h) do { _Pragma("unroll") for (int n = 0; n < 2; ++n) _Pragma("unroll") for (int k = 0; k < 2; ++k) dst[n][k] = *(const PG8_LAS bf16x8*)(lds + PG8_SB(b, h) + boff + n * 2048 + k * 1024); } while (0)
#define PG8_MMA(ai, bj, At, Bt) do { __builtin_amdgcn_s_setprio(1); _Pragma("unroll") for (int m = 0; m < 4; ++m) _Pragma("unroll") for (int n = 0; n < 2; ++n) _Pragma("unroll") for (int k = 0; k < 2; ++k) \
        acc[ai][bj][m][n] = __builtin_amdgcn_mfma_f32_16x16x32_bf16(Bt[n][k], At[m][k], acc[ai][bj][m][n], 0, 0, 0); __builtin_amdgcn_s_setprio(0); } while (0)
#define PG8_WAIT_V(n) asm volatile("s_waitcnt vmcnt(" #n ")" ::: "memory")
#define PG8_WAIT_L(n) asm volatile("s_waitcnt lgkmcnt(" #n ")" ::: "memory")
#define PG8_BAR __builtin_amdgcn_s_barrier()
#define PG8_SCHED __builtin_amdgcn_sched_barrier(0)
    Unit cur, nxt; int ui = 0;
    if (!S.next(0, cur)) return;
    f32x4 acc[2][2][4][2];
#pragma unroll
    for (int a = 0; a < 2; ++a)
#pragma unroll
        for (int b = 0; b < 2; ++b)
#pragma unroll
            for (int m = 0; m < 4; ++m)
#pragma unroll
                for (int n = 0; n < 2; ++n) acc[a][b][m][n] = zero4();
    bf16x8 At[4][2], B0[2][2], B1[2][2];
    const char* cA = (const char*)g.A + (size_t)cur.pm * tstepA + cur.ka; const char* cB = (const char*)g.Bt + (size_t)cur.pn * tstepB + cur.kb;
    S.a_ready(cur);
    if constexpr (SP2) {
        PG8_STAGE(PG8_SB(0, 0), cB, voffB); PG8_STAGE(PG8_SB(0, 1), cB + hstepB, voffB); PG8_STAGE(PG8_SA(0, 0), cA, voffA); PG8_STAGE(PG8_SA(0, 1), cA + hstepA, voffA);
        if (wr == 1) PG8_BAR;
        PG8_WAIT_V(2); PG8_BAR;
        PG8_STAGE(PG8_SB(1, 0), cB + kstep, voffB); PG8_STAGE(PG8_SA(1, 0), cA + kstep, voffA); PG8_STAGE(PG8_SB(1, 1), cB + hstepB + kstep, voffB);
        PG8_WAIT_V(6); PG8_BAR;
    } else {
        PG8_STAGE(PG8_SB(0, 0), cB, voffB); PG8_STAGE(PG8_SA(0, 0), cA, voffA); PG8_STAGE(PG8_SB(0, 1), cB + hstepB, voffB); PG8_STAGE(PG8_SA(0, 1), cA + hstepA, voffA);
        if (wr == 1) PG8_BAR;
        PG8_WAIT_V(4); PG8_BAR;
        PG8_STAGE(PG8_SB(1, 0), cB + kstep, voffB); PG8_STAGE(PG8_SA(1, 0), cA + kstep, voffA); PG8_STAGE(PG8_SB(1, 1), cB + hstepB + kstep, voffB);
        PG8_WAIT_V(6); PG8_BAR;
    }
    for (;;) {
        const bool has_next = S.next(ui + 1, nxt);
        const char* nA = has_next ? (const char*)g.A + (size_t)nxt.pm * tstepA + nxt.ka : cA; const char* nB = has_next ? (const char*)g.Bt + (size_t)nxt.pn * tstepB + nxt.kb : cB;
        for (int t = 0; t < nt; t += 2) {
            const bool last = (t == nt - 2);
            const char* a1 = cA + (size_t)(t + 1) * kstep;
            const char* a2 = last ? nA : cA + (size_t)(t + 2) * kstep; const char* b2 = last ? nB : cB + (size_t)(t + 2) * kstep;
            const char* a3 = a2 + kstep; const char* b3 = b2 + kstep;
            if (last && has_next) S.a_ready(nxt);
            if constexpr (SP2) {
            PG8_LDB(B0, 0, 0); PG8_LDB(B1, 0, 1); PG8_SCHED; PG8_LDA(At, 0, 0); PG8_STAGE(PG8_SA(1, 1), a1 + hstepA, voffA);
            PG8_WAIT_V(8); PG8_WAIT_L(0); PG8_BAR; PG8_MMA(0, 0, At, B0); PG8_MMA(0, 1, At, B1); PG8_BAR; PG8_SCHED;
            PG8_LDA(At, 0, 1); PG8_STAGE(PG8_SB(0, 0), b2, voffB); PG8_STAGE(PG8_SB(0, 1), b2 + hstepB, voffB); PG8_STAGE(PG8_SA(0, 0), a2, voffA);
            PG8_WAIT_V(8); PG8_WAIT_L(0); PG8_BAR; PG8_MMA(1, 0, At, B0); PG8_MMA(1, 1, At, B1); PG8_BAR; PG8_SCHED;
            PG8_LDB(B0, 1, 0); PG8_LDB(B1, 1, 1); PG8_SCHED; PG8_LDA(At, 1, 0); PG8_STAGE(PG8_SA(0, 1), a2 + hstepA, voffA);
            PG8_WAIT_V(8); PG8_WAIT_L(0); PG8_BAR; PG8_MMA(0, 0, At, B0); PG8_MMA(0, 1, At, B1); PG8_BAR; PG8_SCHED;
            PG8_LDA(At, 1, 1); PG8_STAGE(PG8_SB(1, 0), b3, voffB); PG8_STAGE(PG8_SB(1, 1), b3 + hstepB, voffB); PG8_STAGE(PG8_SA(1, 0), a3, voffA);
            PG8_WAIT_V(8); PG8_WAIT_L(0); PG8_BAR; PG8_MMA(1, 0, At, B0); PG8_MMA(1, 1, At, B1); PG8_BAR; PG8_SCHED;
            } else {
            PG8_LDB(B0, 0, 0); PG8_SCHED; PG8_LDA(At, 0, 0); PG8_STAGE(PG8_SA(1, 1), a1 + hstepA, voffA);
            PG8_WAIT_L(8); PG8_BAR; PG8_WAIT_L(0); PG8_MMA(0, 0, At, B0); PG8_BAR; PG8_SCHED;
            PG8_LDB(B1, 0, 1); PG8_STAGE(PG8_SB(0, 0), b2, voffB);
            PG8_BAR; PG8_WAIT_L(0); PG8_MMA(0, 1, At, B1); PG8_BAR;
            PG8_LDA(At, 0, 1); PG8_STAGE(PG8_SA(0, 0), a2, voffA);
            PG8_BAR; PG8_WAIT_L(0); PG8_MMA(1, 0, At, B0); PG8_BAR; PG8_SCHED;
            PG8_STAGE(PG8_SB(0, 1), b2 + hstepB, voffB);
            PG8_WAIT_V(6); PG8_BAR; PG8_MMA(1, 1, At, B1); PG8_BAR;
            PG8_LDB(B0, 1, 0); PG8_SCHED; PG8_LDA(At, 1, 0); PG8_STAGE(PG8_SA(0, 1), a2 + hstepA, voffA);
            PG8_WAIT_L(8); PG8_BAR; PG8_WAIT_L(0); PG8_MMA(0, 0, At, B0); PG8_BAR; PG8_SCHED;
            PG8_LDB(B1, 1, 1); PG8_STAGE(PG8_SB(1, 0), b3, voffB);
            PG8_BAR; PG8_WAIT_L(0); PG8_MMA(0, 1, At, B1); PG8_BAR;
            PG8_LDA(At, 1, 1); PG8_STAGE(PG8_SA(1, 0), a3, voffA);
            PG8_BAR; PG8_WAIT_L(0); PG8_MMA(1, 0, At, B0); PG8_BAR; PG8_SCHED;
            PG8_STAGE(PG8_SB(1, 1), b3 + hstepB, voffB);
            PG8_WAIT_V(6); PG8_BAR; PG8_MMA(1, 1, At, B1); PG8_BAR;
            }
        }
        if constexpr (ALIGN_EPI) { if (wr == 0) PG8_BAR; }
        if constexpr (!Epi::AFTER_DRAIN) { E(acc, cur, wr, wc, fr, fq); S.done(cur); }
        if (!has_next) break;
#pragma unroll
        for (int a = 0; a < 2; ++a)
#pragma unroll
            for (int b = 0; b < 2; ++b)
#pragma unroll
                for (int m = 0; m < 4; ++m)
#pragma unroll
                    for (int n = 0; n < 2; ++n) acc[a][b][m][n] = zero4();
        cur = nxt; cA = nA; cB = nB; ++ui;
        if constexpr (ALIGN_EPI) { if (wr == 1) PG8_BAR; }
    }
    PG8_WAIT_V(0);
    if constexpr (!ALIGN_EPI) { if (wr == 0) PG8_BAR; }
    PG8_BAR;
    if constexpr (Epi::AFTER_DRAIN) { E.fused(acc, cur, wr, wc, fr, fq, lds, wid, lane); S.done(cur); }
#undef PG8_SA
#undef PG8_SB
#undef PG8_STAGE
#undef PG8_LDA
#undef PG8_LDB
#undef PG8_MMA
#undef PG8_WAIT_V
#undef PG8_WAIT_L
#undef PG8_BAR
#undef PG8_SCHED
}
}

typedef unsigned short bf16_t;
typedef short bf16x8 __attribute__((ext_vector_type(8)));
typedef float f32x4 __attribute__((ext_vector_type(4)));
typedef float f32x2 __attribute__((ext_vector_type(2)));
typedef unsigned u32x4 __attribute__((ext_vector_type(4)));
typedef unsigned u32x2 __attribute__((ext_vector_type(2)));
typedef _Float16 h16x8 __attribute__((ext_vector_type(8)));
#define LAS __attribute__((address_space(3)))

constexpr int NTOK = 16384, T = 8192, DM = 1024, DFF = 2816, NWAVES = 8, NTHREADS = 512;
constexpr int NWIN = 4608;
constexpr size_t MiB = 1u << 20;
constexpr size_t WS_WGU1 = 0, WS_WD1 = 11 * MiB, WS_WGU2 = 17 * MiB, WS_WD2 = 28 * MiB, WS_WIN = 34 * MiB, WS_WC1 = 43 * MiB,
                 WS_WBP = 45 * MiB, WS_WBN = 46 * MiB, WS_WO = 48 * MiB, WS_PW = 50 * MiB, WS_POSB = 51 * MiB,
                 WS_HN = 52 * MiB, WS_BIG = 84 * MiB, WS_Q = 84 * MiB, WS_GM = 116 * MiB, WS_KV = 180 * MiB, WS_GN = 204 * MiB,
                 WS_U = 207 * MiB, WS_OPOOL = 223 * MiB, WS_HID = 239 * MiB, WS_KCMP = 243 * MiB, WS_VCMPT = 243 * MiB + 256 * 1024;
constexpr size_t WS_BAR = 244 * MiB;
constexpr size_t KVT = (size_t)4 * 8192 * 64;
constexpr int LDS_BYTES = 143360;
constexpr int NPH_LAYER = 13, NPHASES = 2 * NPH_LAYER + 1;
constexpr float LOG2E = 1.4426950408889634f;
#ifndef ATT_NP
#define ATT_NP 2
#endif
#ifndef PROBE_MASK
#define PROBE_MASK 0
#endif
#ifndef SYNC_REPS
#define SYNC_REPS 1
#endif
#ifndef PHMASK
#define PHMASK 0x1fff
#endif

__device__ __forceinline__ int lane_id_volatile() { int l; asm volatile("v_mbcnt_lo_u32_b32 %0, -1, 0\n\tv_mbcnt_hi_u32_b32 %0, -1, %0" : "=v"(l)); return l; }
__device__ __forceinline__ unsigned f2bf(float f) { unsigned u = __builtin_bit_cast(unsigned, f); return (u + 0x7fffu + ((u >> 16) & 1u)) >> 16; }
__device__ __forceinline__ unsigned pk2(float lo, float hi) { return pg8::cvt_pk_bf16(lo, hi); }
__device__ __forceinline__ float bflo(unsigned w) { return __builtin_bit_cast(float, w << 16); }
__device__ __forceinline__ float bfhi(unsigned w) { return __builtin_bit_cast(float, w & 0xffff0000u); }
__device__ __forceinline__ float sigmoidf_(float x) { return 1.f / (1.f + __expf(-x)); }
__device__ __forceinline__ float sigmoid_fast(float x) { return __builtin_amdgcn_rcpf(1.f + __builtin_amdgcn_exp2f(x * -1.4426950408889634f)); }
__device__ __forceinline__ float shx(float v, int mask, int lane) { return __builtin_bit_cast(float, __builtin_amdgcn_ds_bpermute((lane ^ mask) << 2, __builtin_bit_cast(int, v))); }
__device__ __forceinline__ float wave_sum(float v, int lane) {
#pragma unroll
    for (int o = 1; o < 64; o <<= 1) v += shx(v, o, lane);
    return v;
}


struct EpiGU {
    static constexpr bool PERM = true, AFTER_DRAIN = false;
    bf16_t* O;
    __device__ __forceinline__ void operator()(const f32x4 (&acc)[2][2][4][2], const pg8::Unit& u, int wr, int wc, int, int) const {
        const int ln_ = lane_id_volatile(), fr = ln_ & 15, fq = ln_ >> 4;
        const int row0 = u.pm * 256 + wr * 64 + fr, col0 = u.pn * 128 + wc * 32 + 8 * fq;
#pragma unroll
        for (int ai = 0; ai < 2; ++ai)
#pragma unroll
            for (int m = 0; m < 4; ++m) {
                float r[8];
#pragma unroll
                for (int n = 0; n < 2; ++n)
#pragma unroll
                    for (int i = 0; i < 4; ++i) { const float g = acc[ai][0][m][n][i], up = acc[ai][1][m][n][i]; r[4 * n + i] = g * sigmoid_fast(g) * up; }
                u32x4 w; w.x = pk2(r[0], r[1]); w.y = pk2(r[2], r[3]); w.z = pk2(r[4], r[5]); w.w = pk2(r[6], r[7]);
                *(u32x4*)(O + (size_t)(row0 + ai * 128 + m * 16) * DFF + col0) = w;
            }
    }
};
struct EpiResid {
    static constexpr bool PERM = false, AFTER_DRAIN = false;
    const float* xin; float* xout; float s;
    __device__ __forceinline__ void operator()(const f32x4 (&acc)[2][2][4][2], const pg8::Unit& u, int wr, int wc, int, int) const {
        const int ln_ = lane_id_volatile(), fr = ln_ & 15, fq = ln_ >> 4;
        const int row0 = u.pm * 256 + wr * 64 + fr, col0 = u.pn * 256 + wc * 32 + 4 * fq;
#pragma unroll
        for (int ai = 0; ai < 2; ++ai)
#pragma unroll
            for (int m = 0; m < 4; ++m) {
                const size_t ro = (size_t)(row0 + ai * 128 + m * 16) * DM + col0;
#pragma unroll
                for (int bj = 0; bj < 2; ++bj)
#pragma unroll
                    for (int n = 0; n < 2; ++n) { const f32x4 xi = *(const f32x4*)(xin + ro + bj * 128 + n * 16); *(f32x4*)(xout + ro + bj * 128 + n * 16) = xi + acc[ai][bj][m][n] * s; }
                asm volatile("" ::: "memory");
            }
    }
};
struct EpiSplitK {
    static constexpr bool PERM = false, AFTER_DRAIN = false;
    float* P;
    __device__ __forceinline__ void operator()(const f32x4 (&acc)[2][2][4][2], const pg8::Unit& u, int wr, int wc, int, int) const {
        const int ln_ = lane_id_volatile(), fr = ln_ & 15, fq = ln_ >> 4;
        int fr_ = fr, fq_ = fq; asm volatile("" : "+v"(fr_), "+v"(fq_));
        const int row0 = u.pm * 256 + wr * 64 + fr_, col0 = wc * 32 + 4 * fq_;
        float* base = P + (size_t)(u.ka >> 9) * (4096 * 256);
#pragma unroll
        for (int ai = 0; ai < 2; ++ai)
#pragma unroll
            for (int m = 0; m < 4; ++m) {
                float* rp = base + (size_t)(row0 + ai * 128 + m * 16) * 256 + col0;
#pragma unroll
                for (int bj = 0; bj < 2; ++bj)
#pragma unroll
                    for (int n = 0; n < 2; ++n) *(f32x4*)(rp + bj * 128 + n * 16) = acc[ai][bj][m][n];
            }
    }
};
template <int STAGE> struct EpiMerge {
    static constexpr bool PERM = true, AFTER_DRAIN = false;
    bf16_t* mg; const _Float16* gm;
    __device__ __forceinline__ void operator()(const f32x4 (&acc)[2][2][4][2], const pg8::Unit& u, int wr, int wc, int, int) const {
        const int ln_ = lane_id_volatile(), fr = ln_ & 15, fq = ln_ >> 4;
        const int row0 = u.pm * 256 + wr * 64 + fr, col0 = u.pn * 256 + wc * 32 + 8 * fq;
#pragma unroll
        for (int ai = 0; ai < 2; ++ai)
#pragma unroll
            for (int m = 0; m < 4; ++m) {
                const int row = row0 + ai * 128 + m * 16;
#pragma unroll
                for (int bj = 0; bj < 2; ++bj) {
                    const int col = col0 + bj * 128;
                    const h16x8 gv = *(const h16x8*)(gm + (size_t)row * 2048 + STAGE * 1024 + col);
                    float r[8];
#pragma unroll
                    for (int n = 0; n < 2; ++n)
#pragma unroll
                        for (int i = 0; i < 4; ++i) r[4 * n + i] = (float)gv[4 * n + i] * acc[ai][bj][m][n][i];
                    bf16_t* op = mg + (size_t)row * DM + col;
                    if (STAGE == 1) { const u32x4 pv = *(const u32x4*)op;
                        r[0] += bflo(pv.x); r[1] += bfhi(pv.x); r[2] += bflo(pv.y); r[3] += bfhi(pv.y); r[4] += bflo(pv.z); r[5] += bfhi(pv.z); r[6] += bflo(pv.w); r[7] += bfhi(pv.w); }
                    u32x4 w; w.x = pk2(r[0], r[1]); w.y = pk2(r[2], r[3]); w.z = pk2(r[4], r[5]); w.w = pk2(r[6], r[7]);
                    *(u32x4*)op = w;
                    asm volatile("" ::: "memory");
                }
            }
    }
};
struct EpiWin {
    static constexpr bool PERM = true, AFTER_DRAIN = false;
    bf16_t* q; bf16_t* kv; float* gn; bf16_t* up; _Float16* gm;
    __device__ __forceinline__ void operator()(const f32x4 (&acc)[2][2][4][2], const pg8::Unit& u, int wr, int wc, int, int) const {
        const int ln_ = lane_id_volatile(), fr = ln_ & 15, fq = ln_ >> 4;
        const int pn = u.pn;
        const int row0 = u.pm * 256 + wr * 64 + fr, cin0 = wc * 32 + 8 * fq;
#pragma unroll
        for (int ai = 0; ai < 2; ++ai)
#pragma unroll
            for (int m = 0; m < 4; ++m) {
                const int row = row0 + ai * 128 + m * 16;
#pragma unroll
                for (int bj = 0; bj < 2; ++bj) {
                    const int cin = cin0 + bj * 128;
                    float r[8];
#pragma unroll
                    for (int n = 0; n < 2; ++n)
#pragma unroll
                        for (int i = 0; i < 4; ++i) r[4 * n + i] = acc[ai][bj][m][n][i];
                    if (pn < 4) {
                        u32x4 w; constexpr float QS_ = 0.18033688011112042f;
                        w.x = pk2(r[0] * QS_, r[1] * QS_); w.y = pk2(r[2] * QS_, r[3] * QS_); w.z = pk2(r[4] * QS_, r[5] * QS_); w.w = pk2(r[6] * QS_, r[7] * QS_);
                        *(u32x4*)(q + (size_t)row * DM + pn * 256 + cin) = w;
                    } else if (pn < 7) {
                        const int ti = (pn - 4) * 2 + bj, g = wc >> 1, d0 = 32 * (wc & 1) + 8 * fq, b = row >> 13, t = row & 8191;
                        bf16_t* base = kv + (size_t)ti * KVT;
                        if (ti == 3 || ti == 5) {
                            bf16_t* vb = base + ((size_t)((b * 2 + g) * 128 + (t >> 6)) * 2 + ((t & 63) >> 5)) * 2048 + (t & 31);
#pragma unroll
                            for (int e = 0; e < 8; ++e) vb[(d0 + e) * 32] = (bf16_t)f2bf(r[e]);
                        } else {
                            u32x4 w; w.x = pk2(r[0], r[1]); w.y = pk2(r[2], r[3]); w.z = pk2(r[4], r[5]); w.w = pk2(r[6], r[7]);
                            if (ti < 2) *(u32x4*)(base + ((size_t)((b * 2 + g) * 8192 + t)) * 64 + d0) = w;
                            else *(u32x4*)(base + ((size_t)((b * 2 + g) * 128 + (t >> 6)) * 2 + (d0 >> 5)) * 2048 + (t & 63) * 32 + (d0 & 31)) = w;
                        }
                    } else if (pn < 9) {
                        u32x4 w; w.x = pk2(r[0], r[1]); w.y = pk2(r[2], r[3]); w.z = pk2(r[4], r[5]); w.w = pk2(r[6], r[7]);
                        *(u32x4*)(up + (size_t)row * 512 + (pn - 7) * 256 + cin) = w;
                    } else if (pn < 17) {
                        h16x8 hv;
#pragma unroll
                        for (int e = 0; e < 8; ++e) hv[e] = (_Float16)sigmoid_fast(r[e]);
                        *(h16x8*)(gm + (size_t)row * 2048 + (pn - 9) * 256 + cin) = hv;
                    } else {
                        if (cin < 48) {
#pragma unroll
                            for (int e = 0; e < 8; ++e) gn[(size_t)row * 48 + cin + e] = sigmoidf_(r[e]);
                        }
                    }
                    asm volatile("" ::: "memory");
                }
            }
    }
};
struct CmpOrder {
    int G, c;
    __device__ bool next(int i, pg8::Unit& u) const {
        const int L = i * G + c; if (L >= 128) return false;
        u.pm = L >> 3; u.pn = u.pm >> 3; const int kc = L & 7; u.ka = (long)kc * 512; u.kb = (long)kc * 512; return true;
    }
    __device__ __forceinline__ void a_ready(const pg8::Unit&) const {}
    __device__ __forceinline__ void done(const pg8::Unit&) const {}
};

enum { MAP_PLAIN = 0, MAP_GU = 1, MAP_WIN = 2, MAP_C1 = 3 };
template <int MAP>
__device__ __forceinline__ void cvt_item(const float* s0, const float* s1, int ldsrc, int K, bf16_t* dst, int kb, int nb, float* scr, int lane) {
    const int k0 = 64 * kb, R0 = 32 * nb, n = lane & 31, R = R0 + n;
    const float* src = s0; int col = R;
    if (MAP == MAP_GU) { const int pn = R >> 8, bj = (R >> 7) & 1, j = R & 127; src = bj ? s1 : s0; col = 128 * pn + j; }
    if (MAP == MAP_WIN) { if (R < 1792) col = R; else if (R < 2304) col = 1840 + (R - 1792); else if (R < 4352) col = 2352 + (R - 2304); else if (R < 4400) col = 1792 + (R - 4352); else col = -1; }
    if (MAP == MAP_C1) { if (R >= 256) { src = s1; col = R - 256; } }
    float ld_[32];
    const float* sp_ = src + (size_t)(k0 + (lane >> 5)) * ldsrc + (col >= 0 ? col : 0);
#pragma unroll
    for (int i = 0; i < 32; ++i) ld_[i] = __builtin_nontemporal_load(sp_ + (size_t)(2 * i) * ldsrc);
#pragma unroll
    for (int i = 0; i < 32; ++i) { const int kk = 2 * i + (lane >> 5); scr[kk * 33 + n] = (col >= 0) ? ld_[i] : 0.f; }
    __builtin_amdgcn_fence(__ATOMIC_RELEASE, "wavefront"); __builtin_amdgcn_wave_barrier();
    const int c = lane & 7;
#pragma unroll
    for (int j = 0; j < 4; ++j) { const int nn = (lane >> 3) + 8 * j; const float* s = scr + (8 * c) * 33 + nn;
        u32x4 o; o.x = pk2(s[0 * 33], s[1 * 33]); o.y = pk2(s[2 * 33], s[3 * 33]); o.z = pk2(s[4 * 33], s[5 * 33]); o.w = pk2(s[6 * 33], s[7 * 33]);
        *(u32x4*)(dst + (size_t)(R0 + nn) * K + k0 + 8 * c) = o; }
    __builtin_amdgcn_fence(__ATOMIC_RELEASE, "wavefront"); __builtin_amdgcn_wave_barrier();
}

__device__ __forceinline__ void rms_row_bf16(const float* xrow, const float* gain, bf16_t* orow, int lane) {
    const f32x4* xr = (const f32x4*)xrow + lane; const f32x4* gr = (const f32x4*)gain + lane;
    f32x4 v[4]; float s = 0.f;
#pragma unroll
    for (int j = 0; j < 4; ++j) { v[j] = xr[64 * j]; s += (v[j].x * v[j].x + v[j].y * v[j].y) + (v[j].z * v[j].z + v[j].w * v[j].w); }
    const float r = 1.f / sqrtf(wave_sum(s, lane) * (1.f / DM) + 1e-6f);
    u32x2* o8 = (u32x2*)orow + lane;
#pragma unroll
    for (int j = 0; j < 4; ++j) { const f32x4 g = gr[64 * j]; u32x2 w; w.x = pk2(v[j].x * r * g.x, v[j].y * r * g.y); w.y = pk2(v[j].z * r * g.z, v[j].w * r * g.w); o8[64 * j] = w; }
}
__device__ __forceinline__ void rms_row_f32(const float* xrow, const float* gain, float* orow, int lane) {
    const f32x4* xr = (const f32x4*)xrow + lane; const f32x4* gr = (const f32x4*)gain + lane;
    f32x4 v[4]; float s = 0.f;
#pragma unroll
    for (int j = 0; j < 4; ++j) { v[j] = xr[64 * j]; s += (v[j].x * v[j].x + v[j].y * v[j].y) + (v[j].z * v[j].z + v[j].w * v[j].w); }
    const float r = 1.f / sqrtf(wave_sum(s, lane) * (1.f / DM) + 1e-6f);
    f32x4* o = (f32x4*)orow + lane;
#pragma unroll
    for (int j = 0; j < 4; ++j) { const f32x4 g = gr[64 * j]; o[64 * j] = v[j] * r * g; }
}

template <bool F32OUT>
__device__ __forceinline__ void rms_rows4(const float* x, const float* gain, void* out, int m0, int mstride, int lane) {
    f32x4 v[4][4]; float s[4];
#pragma unroll
    for (int r = 0; r < 4; ++r) { const int mr_ = m0 + r * mstride; const f32x4* xr = (const f32x4*)(x + (size_t)(mr_ < NTOK ? mr_ : m0) * DM) + lane;
#pragma unroll
        for (int j = 0; j < 4; ++j) v[r][j] = xr[64 * j]; }
#pragma unroll
    for (int r = 0; r < 4; ++r) { s[r] = 0.f;
#pragma unroll
        for (int j = 0; j < 4; ++j) s[r] += (v[r][j].x * v[r][j].x + v[r][j].y * v[r][j].y) + (v[r][j].z * v[r][j].z + v[r][j].w * v[r][j].w); }
#pragma unroll
    for (int o = 1; o < 64; o <<= 1)
#pragma unroll
        for (int r = 0; r < 4; ++r) s[r] += shx(s[r], o, lane);
    const f32x4* gr = (const f32x4*)gain + lane;
    f32x4 g[4];
#pragma unroll
    for (int j = 0; j < 4; ++j) g[j] = gr[64 * j];
#pragma unroll
    for (int r = 0; r < 4; ++r) { const int mr_ = m0 + r * mstride; if (mr_ < NTOK) { const float rr = 1.f / sqrtf(s[r] * (1.f / DM) + 1e-6f);
        if (F32OUT) { f32x4* o = (f32x4*)((float*)out + (size_t)mr_ * DM) + lane;
#pragma unroll
            for (int j = 0; j < 4; ++j) o[64 * j] = v[r][j] * rr * g[j]; }
        else { u32x2* o8 = (u32x2*)((bf16_t*)out + (size_t)mr_ * DM) + lane;
#pragma unroll
            for (int j = 0; j < 4; ++j) { u32x2 w; w.x = pk2(v[r][j].x * rr * g[j].x, v[r][j].y * rr * g[j].y); w.y = pk2(v[r][j].z * rr * g[j].z, v[r][j].w * rr * g[j].w); o8[64 * j] = w; } } } }
}

__device__ __forceinline__ bf16x8 ld8(const bf16_t* p) { return *(const bf16x8*)p; }
template <int CTRL> __device__ __forceinline__ float dpp_f(float v) { return __builtin_bit_cast(float, __builtin_amdgcn_update_dpp(0, __builtin_bit_cast(int, v), CTRL, 0xf, 0xf, false)); }
__device__ __forceinline__ int late_head(int g) { return g * 8 + (lane_id_volatile() & 7); }
constexpr int QS = 272;

typedef unsigned v4u32_t __attribute__((ext_vector_type(4)));
struct KvSrc { __amdgpu_buffer_rsrc_t rs; const char* base; unsigned koff, voff; };
template <bool LOADV>
__device__ __forceinline__ void kv_load(const KvSrc& S, const bf16_t* __restrict__ K, const bf16_t* __restrict__ Vt, bf16x8 (&kf)[8], bf16x8 (&vf)[8]) {
    const unsigned sk = (unsigned)((const char*)K - S.base), sv = (unsigned)((const char*)Vt - S.base);
#pragma unroll
    for (int c = 0; c < 2; ++c)
#pragma unroll
        for (int a = 0; a < 2; ++a)
#pragma unroll
            for (int kk = 0; kk < 2; ++kk)
                kf[(c * 2 + a) * 2 + kk] = __builtin_bit_cast(bf16x8, __builtin_amdgcn_raw_buffer_load_b128(S.rs, S.koff + (unsigned)(c * 2048 + a * 256), sk + (unsigned)(kk * 4096), 0));
    if (LOADV) {
#pragma unroll
        for (int dd = 0; dd < 4; ++dd)
#pragma unroll
            for (int c = 0; c < 2; ++c)
                vf[dd * 2 + c] = __builtin_bit_cast(bf16x8, __builtin_amdgcn_raw_buffer_load_b128(S.rs, S.voff + (unsigned)(dd * 1024), sv + (unsigned)(c * 4096), 0));
    }
}

template <int MODE, int KSTEP>
__device__ __forceinline__ void grp_compute(const bf16x8 (&kf)[8], const bf16x8 (&vf)[8], const bf16x8 (&qf)[2], float sl2, int dl, unsigned wlimit, bool lanesel, bool need_mask,
                                            float& m, float& l, f32x4 (&o)[4], float mfix, float* scq, int jbase, int lane) {
    const int mr = lane & 15, kq = lane >> 4;
    const float bl = -sl2 * (float)dl, slk = sl2 * (float)KSTEP;
    f32x4 s[2][2];
#pragma unroll
    for (int c = 0; c < 2; ++c)
#pragma unroll
        for (int a = 0; a < 2; ++a) {
            f32x4 z;
#pragma unroll
            for (int i = 0; i < 4; ++i) z[i] = __builtin_fmaf((float)(32 * c + 4 * a + i), slk, bl);
            z = __builtin_amdgcn_mfma_f32_16x16x32_bf16(kf[(c * 2 + a) * 2 + 0], qf[0], z, 0, 0, 0);
            s[c][a] = __builtin_amdgcn_mfma_f32_16x16x32_bf16(kf[(c * 2 + a) * 2 + 1], qf[1], z, 0, 0, 0);
        }
    if (need_mask) {
#pragma unroll
        for (int c = 0; c < 2; ++c)
#pragma unroll
            for (int a = 0; a < 2; ++a)
#pragma unroll
                for (int i = 0; i < 4; ++i) { const unsigned d = (unsigned)(dl - (32 * c + 4 * a + i) * KSTEP); const bool v = lanesel && (d < wlimit); s[c][a][i] = v ? s[c][a][i] : -1e30f; }
    }
    float bm = -1e30f;
#pragma unroll
    for (int c = 0; c < 2; ++c)
#pragma unroll
        for (int a = 0; a < 2; ++a)
#pragma unroll
            for (int i = 0; i < 4; ++i) bm = fmaxf(bm, s[c][a][i]);
    float sh;
    if (MODE != 2) {
        if (__ballot(bm > m + 16.f) != 0ull) {
            bm = fmaxf(bm, shx(bm, 16, lane)); bm = fmaxf(bm, shx(bm, 32, lane)); const float mn = fmaxf(fmaxf(m, bm), -1e29f);
            const float alpha = __builtin_amdgcn_exp2f(m - mn); m = mn; l = l * alpha;
            if (MODE == 0) {
#pragma unroll
                for (int dd = 0; dd < 4; ++dd) o[dd] = o[dd] * alpha; }
        }
        sh = m;
    } else sh = mfix;
    float ps = 0.f;
#pragma unroll
    for (int c = 0; c < 2; ++c)
#pragma unroll
        for (int a = 0; a < 2; ++a)
#pragma unroll
            for (int i = 0; i < 4; ++i) { const float p = __builtin_amdgcn_exp2f(s[c][a][i] - sh); s[c][a][i] = p; ps += p; }
    if (MODE != 2) l += ps;
    if (MODE != 1) {
#pragma unroll
        for (int c = 0; c < 2; ++c) {
            u32x4 w; w.x = pk2(s[c][0][0], s[c][0][1]); w.y = pk2(s[c][0][2], s[c][0][3]); w.z = pk2(s[c][1][0], s[c][1][1]); w.w = pk2(s[c][1][2], s[c][1][3]);
            const bf16x8 pb = __builtin_bit_cast(bf16x8, w);
#pragma unroll
            for (int dd = 0; dd < 4; ++dd) o[dd] = __builtin_amdgcn_mfma_f32_16x16x32_bf16(vf[dd * 2 + c], pb, o[dd], 0, 0, 0);
        }
    }
    if (MODE == 2) {
#pragma unroll
        for (int c = 0; c < 2; ++c)
#pragma unroll
            for (int a = 0; a < 2; ++a) {
                float h[4];
#pragma unroll
                for (int i = 0; i < 4; ++i) { float v = s[c][a][i]; v += dpp_f<0xB1>(v); v += dpp_f<0x4E>(v); v += dpp_f<0x141>(v); h[i] = v; }
                if ((mr & 7) == 0) { const int j = jbase + 8 * c + 2 * kq + a; scq[j] = h[0] + h[1] + h[2] + 0.5f * h[3]; scq[128 + j + 1] = 0.5f * h[3]; }
            }
    }
}

template <int NP>
__device__ __forceinline__ void attn_item(int bg, int t0, const bf16_t* q, const bf16_t* kvb, const bf16_t* kcmp, const bf16_t* vcmpT, const float* gn, bf16_t* onsa, float* wl  , int lane) {
    constexpr int NQ = 2 * NP;
    const int b = bg >> 1, g = bg & 1, col = lane & 15, kq = lane >> 4, head = g * 8 + (col & 7), qsub = col >> 3;
    const float sl2 = __builtin_amdgcn_exp2f(-0.5f * (float)(head + 1)) * LOG2E;
    int tq[NP];
    bf16x8* qfL = (bf16x8*)(wl + 2 * NP * QS + NP * 4 * 64 * 4) + lane;
    f32x4* totL = (f32x4*)(wl + 2 * NP * QS) + lane;
#pragma unroll
    for (int gi = 0; gi < NP; ++gi) {
        tq[gi] = t0 + 2 * gi + qsub; const size_t row = (size_t)b * T + tq[gi];
        qfL[(gi * 2 + 0) * 64] = ld8(q + row * DM + head * 64 + kq * 8); qfL[(gi * 2 + 1) * 64] = ld8(q + row * DM + head * 64 + 32 + kq * 8);
    }
    KvSrc KS; KS.base = (const char*)kvb; KS.rs = __builtin_amdgcn_make_buffer_rsrc((void*)kvb, (short)0, (int)(WS_VCMPT + 262144 - WS_KV), 0x00020000);
    { const int mr_ = lane & 15; KS.koff = (unsigned)(((8 * (mr_ >> 2) + (mr_ & 3)) * 32 + kq * 8) * 2); KS.voff = (unsigned)((mr_ * 32 + 8 * kq) * 2); }
#pragma unroll
    for (int qi = 0; qi < NQ; ++qi) { float* s_ = wl + qi * QS; s_[lane] = 0.f; s_[lane + 64] = 0.f; s_[128 + lane] = 0.f; s_[192 + lane] = 0.f; if (lane == 0) s_[256] = 0.f; }
    __builtin_amdgcn_fence(__ATOMIC_RELEASE, "wavefront"); __builtin_amdgcn_wave_barrier();
    const int tmax = t0 + NQ - 1;
    const int nv = (tmax >= 31) ? ((tmax - 31) >> 4) + 1 : 0, ncb = (nv + 63) >> 6;
    const int nfull = (t0 >= 31) ? ((((t0 - 31) >> 4) + 1) >> 6) : 0;
    bf16x8 kfA[8], vfA[8], kfB[8], vfB[8];
    {
        const bf16_t* Kc = kcmp + (size_t)bg * 512 * 64; const bf16_t* Vc = vcmpT + (size_t)bg * 512 * 64;
        float m[NP], l[NP], invl[NP]; f32x4 o[NP][4];
#pragma unroll
        for (int gi = 0; gi < NP; ++gi) { m[gi] = -1e29f; l[gi] = 0.f;
#pragma unroll
            for (int dd = 0; dd < 4; ++dd) o[gi][dd] = zero4(); }
        if (ncb > 0) kv_load<false>(KS, Kc + (ncb - 1) * 4096, Vc, kfA, vfA);
        for (int jb = ncb - 1; jb >= 0; --jb) {
            if (jb > 0) kv_load<false>(KS, Kc + (jb - 1) * 4096, Vc, kfB, vfB);
#pragma unroll
            for (int gi = 0; gi < NP; ++gi) { const int dl_ = tq[gi] - (1024 * jb + 31) - 128 * kq;
                { const bf16x8 qv_[2] = {qfL[(gi * 2 + 0) * 64], qfL[(gi * 2 + 1) * 64]}; grp_compute<1, 16>(kfA, vfA, qv_, sl2, dl_, 0x40000000u, true, jb >= nfull, m[gi], l[gi], o[gi], 0.f, wl, 0, lane); } }
#pragma unroll
            for (int e = 0; e < 8; ++e) kfA[e] = kfB[e];
        }
#pragma unroll
        for (int gi = 0; gi < NP; ++gi) { float L = l[gi]; L += shx(L, 16, lane); L += shx(L, 32, lane); invl[gi] = fmaxf(m[gi], -1e29f) + __builtin_amdgcn_logf(fmaxf(L, 1e-30f)); }
        if (ncb > 0) kv_load<true>(KS, Kc, Vc, kfA, vfA);
        for (int jb = 0; jb < ncb; ++jb) {
            if (jb + 1 < ncb) kv_load<true>(KS, Kc + (jb + 1) * 4096, Vc + (jb + 1) * 4096, kfB, vfB);
#pragma unroll
            for (int gi = 0; gi < NP; ++gi) { const int dl_ = tq[gi] - (1024 * jb + 31) - 128 * kq;
                { const bf16x8 qv_[2] = {qfL[(gi * 2 + 0) * 64], qfL[(gi * 2 + 1) * 64]}; grp_compute<2, 16>(kfA, vfA, qv_, sl2, dl_, 0x40000000u, true, jb >= nfull, m[gi], l[gi], o[gi], invl[gi], wl + (2 * gi + qsub) * QS, 16 * jb, lane); } }
#pragma unroll
            for (int e = 0; e < 8; ++e) { kfA[e] = kfB[e]; vfA[e] = vfB[e]; }
        }
#pragma unroll
        for (int gi = 0; gi < NP; ++gi)
#pragma unroll
            for (int dd = 0; dd < 4; ++dd) totL[(gi * 4 + dd) * 64] = o[gi][dd] * gn[((size_t)b * T + tq[gi]) * 48 + late_head(g) * 3 + 0];
    }
    __builtin_amdgcn_fence(__ATOMIC_RELEASE, "wavefront"); __builtin_amdgcn_wave_barrier();
    const int cur = t0 >> 6;
    unsigned long long mk0[NQ], mk1[NQ];
    if (cur < 16) {
#pragma unroll
        for (int qi = 0; qi < NQ; ++qi) { mk0[qi] = (1ull << (cur + 1)) - 1ull; mk1[qi] = 0ull; }
    } else {
#pragma unroll
        for (int qi = 0; qi < NQ; ++qi) {
            const float* sc = wl + qi * QS; const float* hf = sc + 128;
            unsigned u0, u1;
            { const int j = lane; const bool val = j <= cur, forced = val && (j == 0 || j == cur || j == cur - 1); u0 = forced ? 0xFFFFFFFFu : (val ? __builtin_bit_cast(unsigned, sc[j] + hf[j]) + 1u : 0u); }
            { const int j = lane + 64; const bool val = j <= cur, forced = val && (j == cur || j == cur - 1); u1 = forced ? 0xFFFFFFFFu : (val ? __builtin_bit_cast(unsigned, sc[j] + hf[j]) + 1u : 0u); }
            unsigned thr = 0u;
            for (int bit = 31; bit >= 0; --bit) { const unsigned cand = thr | (1u << bit);
                const int cnt = __builtin_popcountll(__ballot(u0 >= cand)) + __builtin_popcountll(__ballot(u1 >= cand));
                thr = (cnt >= 16) ? cand : thr; }
            const unsigned long long gt0 = __ballot(u0 > thr), gt1 = __ballot(u1 > thr), eq0 = __ballot(u0 == thr), eq1 = __ballot(u1 == thr);
            int quota = 16 - __builtin_popcountll(gt0) - __builtin_popcountll(gt1);
            const bool t0_ = (u0 == thr) && ((int)__builtin_amdgcn_mbcnt_hi((unsigned)(eq0 >> 32), __builtin_amdgcn_mbcnt_lo((unsigned)eq0, 0u)) < quota);
            quota -= __builtin_popcountll(eq0);
            const bool t1_ = (u1 == thr) && ((int)__builtin_amdgcn_mbcnt_hi((unsigned)(eq1 >> 32), __builtin_amdgcn_mbcnt_lo((unsigned)eq1, 0u)) < quota);
            mk0[qi] = (gt0 | __ballot(t0_)) & __ballot(lane <= cur); mk1[qi] = (gt1 | __ballot(t1_)) & __ballot(lane + 64 <= cur);
        }
    }
    {
        const bf16_t* Ks = kvb + 2 * KVT + (size_t)bg * 8192 * 64; const bf16_t* Vs = kvb + 3 * KVT + (size_t)bg * 8192 * 64;
        float m[NP], l[NP]; f32x4 o[NP][4];
#pragma unroll
        for (int gi = 0; gi < NP; ++gi) { m[gi] = -1e29f; l[gi] = 0.f;
#pragma unroll
            for (int dd = 0; dd < 4; ++dd) o[gi][dd] = zero4(); }
#pragma unroll
        for (int half = 1; half >= 0; --half) {
            unsigned long long U = 0ull, ug[NP], xg[NP], ma[NP];
#pragma unroll
            for (int gi = 0; gi < NP; ++gi) { const unsigned long long a_ = half ? mk1[2 * gi] : mk0[2 * gi], b_ = half ? mk1[2 * gi + 1] : mk0[2 * gi + 1]; ug[gi] = a_ | b_; xg[gi] = a_ ^ b_; U |= ug[gi]; ma[gi] = a_; }
            if (U) { const int j = half * 64 + 63 - __builtin_clzll(U); kv_load<true>(KS, Ks + (size_t)j * 4096, Vs + (size_t)j * 4096, kfA, vfA); }
            while (U) {
                const int jl = 63 - __builtin_clzll(U), j = half * 64 + jl; U &= ~(1ull << jl);
                if (U) { const int jn = half * 64 + 63 - __builtin_clzll(U); kv_load<true>(KS, Ks + (size_t)jn * 4096, Vs + (size_t)jn * 4096, kfB, vfB); }
#pragma unroll
                for (int gi = 0; gi < NP; ++gi) if ((ug[gi] >> jl) & 1ull) { const int dl_ = tq[gi] - 64 * j - 8 * kq;
                    { const bf16x8 qv_[2] = {qfL[(gi * 2 + 0) * 64], qfL[(gi * 2 + 1) * 64]}; grp_compute<0, 1>(kfA, vfA, qv_, sl2, dl_, 0x40000000u, (((xg[gi] >> jl) & 1ull) == 0ull) || ((int)((ma[gi] >> jl) & 1ull) != qsub), !(j < cur && !((xg[gi] >> jl) & 1ull)), m[gi], l[gi], o[gi], 0.f, wl, 0, lane); } }
#pragma unroll
                for (int e = 0; e < 8; ++e) { kfA[e] = kfB[e]; vfA[e] = vfB[e]; }
            }
        }
#pragma unroll
        for (int gi = 0; gi < NP; ++gi) { float L = l[gi]; L += shx(L, 16, lane); L += shx(L, 32, lane); const float sc1 = gn[((size_t)b * T + tq[gi]) * 48 + late_head(g) * 3 + 1] / fmaxf(L, 1e-30f);
#pragma unroll
            for (int dd = 0; dd < 4; ++dd) totL[(gi * 4 + dd) * 64] = totL[(gi * 4 + dd) * 64] + o[gi][dd] * sc1; }
    }
    {
        const bf16_t* Kw = kvb + 4 * KVT + (size_t)bg * 8192 * 64; const bf16_t* Vw = kvb + 5 * KVT + (size_t)bg * 8192 * 64;
        float m[NP], l[NP]; f32x4 o[NP][4];
#pragma unroll
        for (int gi = 0; gi < NP; ++gi) { m[gi] = -1e29f; l[gi] = 0.f;
#pragma unroll
            for (int dd = 0; dd < 4; ++dd) o[gi][dd] = zero4(); }
        const int j0 = (t0 >= 511) ? ((t0 - 511) >> 6) : 0;
        kv_load<true>(KS, Kw + (size_t)cur * 4096, Vw + (size_t)cur * 4096, kfA, vfA);
        for (int j = cur; j >= j0; --j) {
            if (j > j0) kv_load<true>(KS, Kw + (size_t)(j - 1) * 4096, Vw + (size_t)(j - 1) * 4096, kfB, vfB);
#pragma unroll
            for (int gi = 0; gi < NP; ++gi) { const int dl_ = tq[gi] - 64 * j - 8 * kq;
                { const bf16x8 qv_[2] = {qfL[(gi * 2 + 0) * 64], qfL[(gi * 2 + 1) * 64]}; grp_compute<0, 1>(kfA, vfA, qv_, sl2, dl_, 512u, true, !(64 * j + 63 <= t0 && 64 * j >= tmax - 511), m[gi], l[gi], o[gi], 0.f, wl, 0, lane); } }
#pragma unroll
            for (int e = 0; e < 8; ++e) { kfA[e] = kfB[e]; vfA[e] = vfB[e]; }
        }
#pragma unroll
        for (int gi = 0; gi < NP; ++gi) { float L = l[gi]; L += shx(L, 16, lane); L += shx(L, 32, lane); const float sc2 = gn[((size_t)b * T + tq[gi]) * 48 + late_head(g) * 3 + 2] / fmaxf(L, 1e-30f);
#pragma unroll
            for (int dd = 0; dd < 4; ++dd) o[gi][dd] = totL[(gi * 4 + dd) * 64] + o[gi][dd] * sc2;
            const size_t row = (size_t)b * T + tq[gi];
#pragma unroll
            for (int dd = 0; dd < 4; ++dd) { u32x2 w; w.x = pk2(o[gi][dd][0], o[gi][dd][1]); w.y = pk2(o[gi][dd][2], o[gi][dd][3]);
                *(u32x2*)(onsa + row * DM + late_head(g) * 64 + 16 * dd + 4 * (lane_id_volatile() >> 4)) = w; } }
    }
    __builtin_amdgcn_fence(__ATOMIC_RELEASE, "wavefront"); __builtin_amdgcn_wave_barrier();
}

template <int N> __device__ __forceinline__ float ror16(float v) { return __builtin_bit_cast(float, __builtin_amdgcn_update_dpp(0, __builtin_bit_cast(int, v), 0x120 + N, 0xf, 0xf, false)); }
template <int N> __device__ __forceinline__ void pool_step(float (&c)[8], float (&p)[8], int mr) {
#pragma unroll
    for (int e = 0; e < 8; ++e) { const float rc = ror16<N>(c[e]), rp = ror16<N>(p[e]); c[e] += (mr >= N) ? rc : rp; p[e] += rp; }
}
__device__ __forceinline__ void pool_delta(const bf16_t* U, int row, int t, int gi, int kq, int mr, bf16x8 (&af)[4]) {
    const int w = 2 << gi;
    const float ic = 1.f / (float)((t + 1 < w) ? (t + 1) : w);
    const bool first = ((row - mr) & 8191) == 0;
    u32x4 cu[4], pu[4];
#pragma unroll
    for (int kk = 0; kk < 4; ++kk) { const bf16_t* up = U + (size_t)row * 512 + gi * 128 + kk * 32 + kq * 8; cu[kk] = *(const u32x4*)up; pu[kk] = first ? (u32x4){0u, 0u, 0u, 0u} : *(const u32x4*)(up - 16 * 512); }
#pragma unroll
    for (int kk = 0; kk < 4; ++kk) {
        float c[8] = {bflo(cu[kk].x), bfhi(cu[kk].x), bflo(cu[kk].y), bfhi(cu[kk].y), bflo(cu[kk].z), bfhi(cu[kk].z), bflo(cu[kk].w), bfhi(cu[kk].w)};
        float p[8] = {bflo(pu[kk].x), bfhi(pu[kk].x), bflo(pu[kk].y), bfhi(pu[kk].y), bflo(pu[kk].z), bfhi(pu[kk].z), bflo(pu[kk].w), bfhi(pu[kk].w)};
        pool_step<1>(c, p, mr);
        if (gi >= 1) pool_step<2>(c, p, mr);
        if (gi >= 2) pool_step<4>(c, p, mr);
        if (gi >= 3) pool_step<8>(c, p, mr);
        const u32x4 self = cu[kk];
        u32x4 d; d.x = pk2(c[0] * ic - bflo(self.x), c[1] * ic - bfhi(self.x)); d.y = pk2(c[2] * ic - bflo(self.y), c[3] * ic - bfhi(self.y));
        d.z = pk2(c[4] * ic - bflo(self.z), c[5] * ic - bfhi(self.z)); d.w = pk2(c[6] * ic - bflo(self.w), c[7] * ic - bfhi(self.w));
        af[kk] = __builtin_bit_cast(bf16x8, d);
    }
}

#define XB_TMO      128
#define XB_XCNT(j)  (256  + 64 * (j))
#define XB_XSUB(j)  (1280 + 64 * (j))
#define XB_XGEN(j)  (2304 + 64 * (j))
#define XB_TOP      3328
#define XB_TOPGEN   3392
#define XCD_BAR_WORDS 3456
#define XB_SPIN_CAP (1u << 18)

__device__ __forceinline__ unsigned xb_ld(unsigned* p)              { return __hip_atomic_load(p, __ATOMIC_RELAXED, __HIP_MEMORY_SCOPE_AGENT); }
__device__ __forceinline__ unsigned xb_add(unsigned* p, unsigned v) { return __hip_atomic_fetch_add(p, v, __ATOMIC_RELAXED, __HIP_MEMORY_SCOPE_AGENT); }
__device__ __forceinline__ unsigned xb_xcc_id() { return (unsigned)__builtin_amdgcn_s_getreg((3 << 11) | 20) & 0xFu; }
#define XB_SPIN(cond, bar) do { unsigned _sp = 0; while (cond) { __builtin_amdgcn_s_sleep(1); \
    if ((++_sp & 255u) == 0u) { if (xb_ld(&(bar)[XB_TMO])) break; if (_sp > XB_SPIN_CAP) { atomicAdd(&(bar)[XB_TMO], 1u); break; } } } } while (0)

struct XcdBarrier {
    unsigned* bar; unsigned x;
    volatile LAS unsigned* st;
};

__device__ __forceinline__ XcdBarrier xcd_barrier_post(unsigned* bar, volatile LAS unsigned* st) {
    XcdBarrier b; b.bar = bar; b.x = xb_xcc_id(); b.st = st;
    if (threadIdx.x == 0) (void)xb_add(&bar[XB_XCNT(b.x)], 1u);
    return b;
}
__device__ __forceinline__ void xcd_barrier_complete(unsigned* bar, unsigned x, unsigned& nloc, unsigned& nx) {
    const unsigned G = gridDim.x * gridDim.y * gridDim.z;
    unsigned sum, cnt, mine, sp = 0u;
    for (;;) {
        sum = 0u; cnt = 0u; mine = 0u;
#pragma unroll
        for (unsigned j = 0; j < 16; ++j) { const unsigned c = xb_ld(&bar[XB_XCNT(j)]); sum += c; cnt += (c > 0u) ? 1u : 0u; mine = (j == x) ? c : mine; }
        if (sum == G) break;
        __builtin_amdgcn_s_sleep(1);
        if ((++sp & 255u) == 0u) { if (xb_ld(&bar[XB_TMO])) break; if (sp > XB_SPIN_CAP) { atomicAdd(&bar[XB_TMO], 1u); break; } }
    }
    nloc = mine > 0u ? mine : 1u; nx = cnt > 0u ? cnt : 1u;
}

__device__ __forceinline__ void xcd_barrier(const XcdBarrier& b, int tid) {
    asm volatile("s_waitcnt vmcnt(0)" ::: "memory");
    __syncthreads();
    if (tid == 0) {
        unsigned* bar = b.bar;
        __builtin_amdgcn_s_waitcnt(0);
        unsigned nloc = b.st[0], nx = b.st[1];
        if (nloc == 0u) { xcd_barrier_complete(bar, b.x, nloc, nx); b.st[0] = nloc; b.st[1] = nx; }
        const unsigned old = xb_add(&bar[XB_XSUB(b.x)], 1u);
        const unsigned gen = old / nloc;
        if (old + 1u == (gen + 1u) * nloc) {
            __builtin_amdgcn_fence(__ATOMIC_RELEASE, "agent");
            asm volatile("s_waitcnt vmcnt(0)" ::: "memory");
            const unsigned og = xb_add(&bar[XB_TOP], 1u);
            const unsigned tg = og / nx;
            if (og + 1u == (tg + 1u) * nx) xb_add(&bar[XB_TOPGEN], 1u);
            else XB_SPIN(xb_ld(&bar[XB_TOPGEN]) == tg, bar);
            __builtin_amdgcn_fence(__ATOMIC_ACQUIRE, "agent");
            xb_add(&bar[XB_XGEN(b.x)], 1u);
            asm volatile("s_waitcnt vmcnt(0)" ::: "memory");
        } else {
            XB_SPIN(xb_ld(&bar[XB_TOPGEN]) == gen, bar);
            __builtin_amdgcn_fence(__ATOMIC_ACQUIRE, "agent");
            asm volatile("s_waitcnt vmcnt(0)" ::: "memory");
        }
    }
    __syncthreads();
}


struct Args { const float* in[22]; float* out; unsigned char* ws; int ph_lo, ph_hi; };

typedef const __attribute__((address_space(4))) Args* ArgsP;
__device__ __forceinline__ void convert_weights(ArgsP ap, int l, unsigned char* ws, float* scr, int lane, int wv, int nw, unsigned mask) {
    const auto& args = *ap;
    const float* wg1 = args.in[2] + (size_t)l * DM * DFF; const float* wu1 = args.in[3] + (size_t)l * DM * DFF; const float* wd1 = args.in[4] + (size_t)l * DFF * DM;
    const float* wg2 = args.in[18] + (size_t)l * DM * DFF; const float* wu2 = args.in[19] + (size_t)l * DM * DFF; const float* wd2 = args.in[20] + (size_t)l * DFF * DM;
    const float* win = args.in[6] + (size_t)l * DM * 4400;
    const float* w1k = args.in[8] + (size_t)l * 2048 * 256; const float* w1v = args.in[10] + (size_t)l * 2048 * 256;
    const float* pw = args.in[12] + (size_t)l * 4 * 128 * 128;
    const float* wbp = args.in[14] + (size_t)l * 512 * DM; const float* wbn = args.in[15] + (size_t)l * DM * DM; const float* wo = args.in[16] + (size_t)l * DM * DM;
    constexpr int I_GU = 16 * 176, I_D = 44 * 32, I_WIN = 16 * 144, I_C1 = 32 * 16, I_BP = 8 * 32, I_BN = 16 * 32, I_WO = 16 * 32, I_PW = 32;
    constexpr int NIT = 2 * I_GU + 2 * I_D + I_WIN + I_C1 + I_BP + I_BN + I_WO + I_PW;
    for (int it = wv; it < NIT; it += nw) {
        int r = it;
        if (r < I_GU) { if ((mask >> 0) & 1u) cvt_item<MAP_GU>(wg1, wu1, DFF, DM, (bf16_t*)(ws + WS_WGU1), r / 176, r % 176, scr, lane); continue; } r -= I_GU;
        if (r < I_GU) { if ((mask >> 1) & 1u) cvt_item<MAP_GU>(wg2, wu2, DFF, DM, (bf16_t*)(ws + WS_WGU2), r / 176, r % 176, scr, lane); continue; } r -= I_GU;
        if (r < I_D) { if ((mask >> 2) & 1u) cvt_item<MAP_PLAIN>(wd1, wd1, DM, DFF, (bf16_t*)(ws + WS_WD1), r / 32, r % 32, scr, lane); continue; } r -= I_D;
        if (r < I_D) { if ((mask >> 3) & 1u) cvt_item<MAP_PLAIN>(wd2, wd2, DM, DFF, (bf16_t*)(ws + WS_WD2), r / 32, r % 32, scr, lane); continue; } r -= I_D;
        if (r < I_WIN) { if ((mask >> 4) & 1u) cvt_item<MAP_WIN>(win, win, 4400, DM, (bf16_t*)(ws + WS_WIN), r / 144, r % 144, scr, lane); continue; } r -= I_WIN;
        if (r < I_C1) { if ((mask >> 5) & 1u) cvt_item<MAP_C1>(w1k, w1v, 256, 2048, (bf16_t*)(ws + WS_WC1), r / 16, r % 16, scr, lane); continue; } r -= I_C1;
        if (r < I_BP) { if ((mask >> 6) & 1u) cvt_item<MAP_PLAIN>(wbp, wbp, DM, 512, (bf16_t*)(ws + WS_WBP), r / 32, r % 32, scr, lane); continue; } r -= I_BP;
        if (r < I_BN) { if ((mask >> 7) & 1u) cvt_item<MAP_PLAIN>(wbn, wbn, DM, DM, (bf16_t*)(ws + WS_WBN), r / 32, r % 32, scr, lane); continue; } r -= I_BN;
        if (r < I_WO) { if ((mask >> 8) & 1u) cvt_item<MAP_PLAIN>(wo, wo, DM, DM, (bf16_t*)(ws + WS_WO), r / 32, r % 32, scr, lane); continue; } r -= I_WO;
        { const int gi = r >> 3, rr = r & 7; if ((mask >> 9) & 1u) cvt_item<MAP_PLAIN>(pw + gi * 16384, pw, 128, 128, (bf16_t*)(ws + WS_PW) + gi * 16384, rr >> 2, rr & 3, scr, lane); }
    }
}

__device__ __forceinline__ void run_phase(ArgsP ap, int ph, unsigned char* lds, int rep, int wave_s) {
    const auto& args = *ap;
    int bid_ = blockIdx.x; asm volatile("" : "+s"(bid_));
    const int wave = wave_s;
    const int G = gridDim.x, bid = bid_, gw = bid * NWAVES + wave, NGW = G * NWAVES;
#define PHASE_IDS const int tid = wave_s * 64 + lane_id_volatile(); const int lane = tid & 63; (void)tid; (void)lane
    unsigned char* ws = args.ws;
    PG8_LAS unsigned char* ldsl = (PG8_LAS unsigned char*)lds;
    bf16_t* HN = (bf16_t*)(ws + WS_HN); bf16_t* HFF = (bf16_t*)(ws + WS_BIG); bf16_t* Q = (bf16_t*)(ws + WS_Q); _Float16* GM = (_Float16*)(ws + WS_GM);
    bf16_t* KV = (bf16_t*)(ws + WS_KV); float* GN = (float*)(ws + WS_GN); bf16_t* U = (bf16_t*)(ws + WS_U); bf16_t* OPOOL = (bf16_t*)(ws + WS_OPOOL);
    float* HID = (float*)(ws + WS_HID); bf16_t* KCMP = (bf16_t*)(ws + WS_KCMP); bf16_t* VCMPT = (bf16_t*)(ws + WS_VCMPT); float* POSB = (float*)(ws + WS_POSB);
    bf16_t* ONSA = HN; bf16_t* MG = Q;
    float* X = args.out;
    if (ph == 2 * NPH_LAYER) {
        PHASE_IDS;
        for (int mrow = gw; mrow < NTOK; mrow += 4 * NGW) rms_rows4<true>(X, args.in[21], X, mrow, NGW, lane);
        return;
    }
    const int l = ph / NPH_LAYER, p = ph % NPH_LAYER;
    if (!((PHMASK >> p) & 1)) return;
    switch (p) {
    case 0: {
        PHASE_IDS;
        float* scr = (float*)lds + wave * (64 * 33);
        const float* w1k = args.in[8] + (size_t)l * 2048 * 256; const float* w1v = args.in[10] + (size_t)l * 2048 * 256;
        constexpr unsigned CV_A = 1u << 0, CV_B = (1u << 2) | (1u << 4) | (1u << 5) | (1u << 9), CV_C = (1u << 1) | (1u << 3) | (1u << 6) | (1u << 7) | (1u << 8);
        convert_weights(ap, l, ws, scr, lane, gw, NGW, (G == 256) ? CV_A : (CV_A | CV_B | CV_C));
        const float* xin = (l == 0) ? args.in[0] : X;
        const float* gain = args.in[1] + l * DM;
        for (int mrow = gw; mrow < NTOK; mrow += 4 * NGW) rms_rows4<false>(xin, gain, HN, mrow, NGW, lane);
        const float* pos = args.in[7] + l * 2048;
        for (int it = gw; it < 512; it += NGW) { const int kvs = it >> 8, j = it & 255; const float* w1 = kvs ? w1v : w1k; float s = 0.f;
            for (int i = 0; i < 32; ++i) { const int k = lane + 64 * i; s += pos[k] * w1[(size_t)k * 256 + j]; }
            s = wave_sum(s, lane); if (lane == 0) POSB[it] = s; }
        break; }
    case 1: case 11: {
        PHASE_IDS;
        pg8::Gemm g{HN, (const bf16_t*)(ws + (p == 1 ? WS_WGU1 : WS_WGU2)), NTOK, 2 * DFF, DM, DM, DM}; pg8::StaticOrder S; S.init(NTOK, 2 * DFF, G, bid);
        EpiGU E{HFF};
        pg8::gemm_phase<EpiGU, pg8::StaticOrder, true, true>(ldsl, g, S, E, tid);
        if (p == 1 && G == 256 && bid >= 128) {
            const int lane2 = lane_id_volatile();
            convert_weights(ap, l, ws, (float*)lds + wave * (64 * 33), lane2, (bid - 128) * NWAVES + wave, 128 * NWAVES, (1u << 2) | (1u << 4) | (1u << 5) | (1u << 9));
        }
        break; }
    case 2: case 12: {
        PHASE_IDS;
        pg8::Gemm g{HFF, (const bf16_t*)(ws + (p == 2 ? WS_WD1 : WS_WD2)), NTOK, DM, DFF, DFF, DFF}; pg8::StaticOrder S; S.init(NTOK, DM, G, bid);
        EpiResid E{(l == 0 && p == 2 && rep == 0) ? args.in[0] : X, X, rep ? 0.f : 0.5f};
        pg8::gemm_phase<EpiResid, pg8::StaticOrder, true, true>(ldsl, g, S, E, tid);
        break; }
    case 3: case 10: {
        PHASE_IDS;
        const float* gain = (p == 3 ? args.in[5] : args.in[17]) + l * DM;
        for (int mrow = gw; mrow < NTOK; mrow += 4 * NGW) rms_rows4<false>(X, gain, HN, mrow, NGW, lane);
        break; }
    case 4: {
        PHASE_IDS;
        pg8::Gemm g{HN, (const bf16_t*)(ws + WS_WIN), NTOK, NWIN, DM, DM, DM}; pg8::StaticOrder S; S.init(NTOK, NWIN, G, bid);
        EpiWin E{Q, KV, GN, U, GM};
        pg8::gemm_phase<EpiWin, pg8::StaticOrder, true, true>(ldsl, g, S, E, tid);
        if (G == 256 && bid >= 128) {
            const int lane2 = lane_id_volatile();
            convert_weights(ap, l, ws, (float*)lds + wave * (64 * 33), lane2, (bid - 128) * NWAVES + wave, 128 * NWAVES, (1u << 1) | (1u << 3) | (1u << 6) | (1u << 7) | (1u << 8));
        }
        break; }
    case 5: {
        PHASE_IDS;
        { pg8::Gemm g{KV, (const bf16_t*)(ws + WS_WC1), 4096, 512, 256, 1024, 2048}; CmpOrder S{G, bid}; EpiSplitK E{(float*)HN};
          pg8::gemm_phase<EpiSplitK, CmpOrder, true, true>(ldsl, g, S, E, tid); }
        const bf16_t* PWT = (const bf16_t*)(ws + WS_PW); const float* pscale = args.in[13] + l * 512;
        const int lane2 = lane_id_volatile();
        const int mr = lane2 & 15, kq = lane2 >> 4;
        const int gi = gw & 3, wq = gw >> 2, nwq = NGW >> 2;
        bf16x8 bw[8][4];
#pragma unroll
        for (int nn = 0; nn < 8; ++nn)
#pragma unroll
            for (int kk = 0; kk < 4; ++kk) bw[nn][kk] = ld8(PWT + (size_t)gi * 16384 + (16 * nn + mr) * 128 + kk * 32 + kq * 8);
        f32x4 scv[8];
#pragma unroll
        for (int nn = 0; nn < 8; ++nn) scv[nn] = *(const f32x4*)(pscale + gi * 128 + 16 * nn + 4 * kq);
        const bool deal_ = (G == 256);
        const int tt_first = deal_ ? (bid < 128 ? wq : wq) : wq, tt_step = deal_ ? 256 : nwq, tt_end = deal_ ? (bid < 128 ? 256 : 1024) : 1024;
        for (int tt = tt_first; tt < tt_end; tt += tt_step) {
            const int row = tt * 16 + mr, t = row & 8191;
            bf16x8 af[4];
            pool_delta(U, row, t, gi, kq, mr, af);
#pragma unroll
            for (int nn = 0; nn < 8; ++nn) {
                f32x4 acc = zero4();
#pragma unroll
                for (int kk = 0; kk < 4; ++kk) acc = __builtin_amdgcn_mfma_f32_16x16x32_bf16(bw[nn][kk], af[kk], acc, 0, 0, 0);
                const int c0 = gi * 128 + 16 * nn + 4 * kq;
                u32x2 o; o.x = pk2(acc[0] * scv[nn][0], acc[1] * scv[nn][1]); o.y = pk2(acc[2] * scv[nn][2], acc[3] * scv[nn][3]);
                *(u32x2*)(OPOOL + (size_t)row * 512 + c0) = o;
            }
        }
        break; }
    case 6: {
        PHASE_IDS;
        float* w2s = (float*)lds; float* hs = (float*)lds + 16384 + wave * 256;
        for (int rb = bid; rb < 256; rb += G) {
            const int kvs = rb >> 7; const float* w2 = (kvs ? args.in[11] : args.in[9]) + (size_t)l * 256 * 64;
            __syncthreads();
            for (int i = tid; i < 16384 / 4; i += NTHREADS) ((f32x4*)w2s)[i] = ((const f32x4*)w2)[i];
            __syncthreads();
            for (int rr = 0; rr < 2; ++rr) {
                const int rowi = rb * 16 + wave * 2 + rr, r2 = rowi & 2047, bg = r2 >> 9, n = r2 & 511;
                float outv = 0.f;
                if (n < 511) {
#pragma unroll
                    for (int i = 0; i < 4; ++i) { const int j = lane + 64 * i; float x = POSB[kvs * 256 + j]; { const float* pp = (const float*)HN + (size_t)rowi * 256 + j;
#pragma unroll
                        for (int kc = 0; kc < 8; ++kc) x += pp[(size_t)kc * (4096 * 256)]; }
                        const float y = 0.7978845608028654f * (x + 0.044715f * x * x * x); const float th = 1.f - 2.f / (1.f + __expf(2.f * y)); hs[j] = 0.5f * x * (1.f + th); }
                    __builtin_amdgcn_fence(__ATOMIC_RELEASE, "wavefront"); __builtin_amdgcn_wave_barrier();
                    for (int j = 0; j < 256; ++j) outv += hs[j] * w2s[j * 64 + lane];
                    __builtin_amdgcn_fence(__ATOMIC_RELEASE, "wavefront"); __builtin_amdgcn_wave_barrier();
                }
                if (kvs == 0) KCMP[((size_t)(bg * 8 + (n >> 6)) * 2 + (lane >> 5)) * 2048 + (n & 63) * 32 + (lane & 31)] = (bf16_t)f2bf(outv);
                else VCMPT[((size_t)(bg * 8 + (n >> 6)) * 2 + ((n & 63) >> 5)) * 2048 + lane * 32 + (n & 31)] = (bf16_t)f2bf(outv);
            }
        }
        break; }
    case 7: {
        PHASE_IDS;
        constexpr int NP = ATT_NP, NQ = 2 * NP;
        float* wl = (float*)lds + wave * (NQ * QS + NP * 4 * 64 * 4 + NP * 2 * 64 * 4);
        if ((G & 7) == 0) {
            const int xcd = bid & 7, bg = xcd >> 1, hx = xcd & 1, lw = (bid >> 3) * NWAVES + wave, nlw = (G >> 3) * NWAVES;
            for (int i = lw; i < T / NQ / 2; i += nlw) attn_item<NP>(bg, (2 * i + hx) * NQ, Q, KV, KCMP, VCMPT, GN, ONSA, wl, lane);
        } else {
            for (int qi = gw; qi < 4 * T / NQ; qi += NGW) attn_item<NP>((qi * NQ) >> 13, (qi * NQ) & 8191, Q, KV, KCMP, VCMPT, GN, ONSA, wl, lane);
        }
        break; }
    case 8: {
        PHASE_IDS;
        { pg8::Gemm g{OPOOL, (const bf16_t*)(ws + WS_WBP), NTOK, DM, 512, 512, 512}; pg8::StaticOrder S; S.init(NTOK, DM, G, bid); EpiMerge<0> E{MG, GM};
          pg8::gemm_phase<EpiMerge<0>, pg8::StaticOrder, true, true>(ldsl, g, S, E, tid); }
        __syncthreads();
        { pg8::Gemm g{ONSA, (const bf16_t*)(ws + WS_WBN), NTOK, DM, DM, DM, DM}; pg8::StaticOrder S; S.init(NTOK, DM, G, bid); EpiMerge<1> E{MG, GM};
          pg8::gemm_phase<EpiMerge<1>, pg8::StaticOrder, true, true>(ldsl, g, S, E, tid); }
        break; }
    case 9: {
        PHASE_IDS;
        pg8::Gemm g{MG, (const bf16_t*)(ws + WS_WO), NTOK, DM, DM, DM, DM}; pg8::StaticOrder S; S.init(NTOK, DM, G, bid);
        EpiResid E{X, X, rep ? 0.f : 1.0f};
        pg8::gemm_phase<EpiResid, pg8::StaticOrder, true, true>(ldsl, g, S, E, tid);
        break; }
    default: break;
    }
}

__global__ void __launch_bounds__(NTHREADS, 2) fwd_kernel(Args args) {
    extern __shared__ __attribute__((aligned(16))) unsigned char lds[];
    cg::grid_group grid = cg::this_grid();
    const int ph_lo = args.ph_lo, ph_hi = args.ph_hi;
    volatile LAS unsigned* bst = (volatile LAS unsigned*)((LAS unsigned char*)lds + (LDS_BYTES - 64));
    const int wave_s = __builtin_amdgcn_readfirstlane((int)threadIdx.x >> 6);
    if (threadIdx.x == 0) { bst[0] = 0u; bst[1] = 0u; }
    __syncthreads();
    (void)xcd_barrier_post((unsigned*)(args.ws + WS_BAR), bst);
    if (ph_hi < 0) grid.sync();
    for (int ph = ph_lo; ph < ph_hi; ++ph) {
        ArgsP ap = (ArgsP)__builtin_amdgcn_kernarg_segment_ptr(); asm volatile("" : "+s"(ap));
        { const int pp = ph % NPH_LAYER; const int reps = (((PROBE_MASK >> pp) & 1) && ph < 2 * NPH_LAYER) ? 2 : 1; for (int r = 0; r < reps; ++r) { if (r) __syncthreads(); run_phase(ap, ph, lds, r, wave_s); } }
        if (ph + 1 < ph_hi) for (int sr = 0; sr < SYNC_REPS; ++sr) {
            XcdBarrier xb2; xb2.bar = (unsigned*)(ap->ws + WS_BAR); xb2.x = xb_xcc_id(); xb2.st = (volatile LAS unsigned*)((LAS unsigned char*)lds + (LDS_BYTES - 64));
            xcd_barrier(xb2, wave_s * 64 + lane_id_volatile()); }
    }
}

#ifndef N_LAUNCH_MODE
#define N_LAUNCH_MODE 0
#endif

extern "C" void kernel_launch(void* const* d_in, const int* in_sizes, int n_in, void* d_out, int out_size, void* d_ws, size_t ws_size, hipStream_t stream) {
    static int grid = 0;
    if (grid == 0) {
        int dev = 0, cus = 0, per_cu = 0;
        (void)hipGetDevice(&dev);
        (void)hipDeviceGetAttribute(&cus, hipDeviceAttributeMultiprocessorCount, dev);
        (void)hipFuncSetAttribute((const void*)fwd_kernel, hipFuncAttributeMaxDynamicSharedMemorySize, LDS_BYTES);
        (void)hipOccupancyMaxActiveBlocksPerMultiprocessor(&per_cu, (const void*)fwd_kernel, NTHREADS, LDS_BYTES);
        if (per_cu < 1) per_cu = 1;
        grid = cus * per_cu;
        if (grid > 256) grid = 256;
        (void)hipGetLastError();
    }
    (void)hipMemsetAsync((char*)d_ws + WS_BAR, 0, XCD_BAR_WORDS * 4, stream);
    Args a{};
    for (int i = 0; i < 22; ++i) a.in[i] = (const float*)d_in[i];
    a.out = (float*)d_out; a.ws = (unsigned char*)d_ws;
#if N_LAUNCH_MODE == 0
    a.ph_lo = 0; a.ph_hi = NPHASES;
    void* kargs[] = {&a};
    hipError_t e = hipLaunchCooperativeKernel((const void*)fwd_kernel, dim3(grid), dim3(NTHREADS), kargs, LDS_BYTES, stream);
    if (e != hipSuccess) fprintf(stderr, "cooperative launch failed: %s (grid %d)\n", hipGetErrorString(e), grid);
#else
    for (int ph = 0; ph < NPHASES; ++ph) {
        a.ph_lo = ph; a.ph_hi = ph + 1;
        hipLaunchKernelGGL(fwd_kernel, dim3(grid), dim3(NTHREADS), LDS_BYTES, stream, a);
    }
#endif
}
```

```cpp
#include <hip/hip_runtime.h>
#include <hip/hip_cooperative_groups.h>
#include <cstdio>
#include <cstdint>
namespace cg = cooperative_groups;
typedef float f32x4_z __attribute__((ext_vector_type(4)));
__device__ __forceinline__ f32x4_z zero4() { float z = 0.f; asm volatile("" : "+v"(z)); return (f32x4_z){z, z, z, z}; }
namespace pg8 {
#define PG8_LAS __attribute__((address_space(3)))
typedef unsigned short bf16_t;
typedef short bf16x8 __attribute__((ext_vector_type(8)));
typedef float f32x4 __attribute__((ext_vector_type(4)));
typedef unsigned u32x4 __attribute__((ext_vector_type(4)));
constexpr int BM = 256, BK = 64, HALF = 128, HTB = HALF * BK * 2  , STAGE_BYTES = 8 * HTB, NXCD = 8, WGM = 8;

__host__ __device__ __forceinline__ int lds_byte(int r, int c) { const int st = (r >> 4) * 2 + (c >> 5), rr = r & 15, cc = c & 31, ob = rr * 64 + cc * 2; return st * 1024 + (ob ^ (((ob >> 9) & 1) << 5)); }
__host__ __device__ __forceinline__ void stage_rc(int b, int& R, int& C) { const int st = b / 1024, sb = b % 1024, swz = sb ^ (((sb >> 9) & 1) << 5); R = (st >> 1) * 16 + swz / 64; C = (st & 1) * 32 + (swz % 64) / 2; }
__host__ __device__ __forceinline__ int perm32(int rho) { const int n = rho >> 4, i = rho & 15; return 8 * (i >> 2) + 4 * n + (i & 3); }

struct Unit { int pm, pn; long ka, kb; };
struct Gemm { const bf16_t* A; const bf16_t* Bt; int M, N, K, lda, ldb; };

struct StaticOrder {
    int nM, nN, nwg, G, c;
    __host__ __device__ void init(int M, int N, int G_, int c_) { nM = M / BM; nN = N / BM; nwg = nM * nN; G = G_; c = c_; }
    __host__ __device__ bool next(int i, Unit& u) const {
        const long L = (long)i * G + c; if (L >= nwg) return false;
        int wgid = (int)L; { const int q = nwg / NXCD, r = nwg % NXCD, xcd = wgid % NXCD, off = wgid / NXCD; wgid = (xcd < r ? xcd * (q + 1) : r * (q + 1) + (xcd - r) * q) + off; }
        const int nig = WGM * nN, gid = wgid / nig, fm = gid * WGM, gsz = (nM - fm) < WGM ? (nM - fm) : WGM;
        u.pm = fm + ((wgid % nig) % gsz); u.pn = (wgid % nig) / gsz; u.ka = 0; u.kb = 0; return true;
    }
    __device__ __forceinline__ void a_ready(const Unit&) const {}
    __device__ __forceinline__ void done(const Unit&) const {}
};
struct CountedOrder : StaticOrder {
    const unsigned* ready; unsigned need; int wave;
    __device__ __forceinline__ void a_ready(const Unit& u) const {
        if (need == 0u) return;
        if (wave == 0) {
            unsigned spins = 0u;
            while ((unsigned)__builtin_amdgcn_readfirstlane((int)__hip_atomic_load(ready + 64 * u.pm, __ATOMIC_RELAXED, __HIP_MEMORY_SCOPE_AGENT)) < need) {
                __builtin_amdgcn_s_sleep(2); if (++spins > (1u << 22)) break; }
            __builtin_amdgcn_fence(__ATOMIC_ACQUIRE, "agent");
            asm volatile("s_waitcnt vmcnt(0)" ::: "memory");
        }
        asm volatile("" ::: "memory"); __builtin_amdgcn_s_barrier(); asm volatile("" ::: "memory");
    }
};
__device__ __forceinline__ unsigned cvt_pk_bf16(float lo, float hi) { unsigned r; asm volatile("v_cvt_pk_bf16_f32 %0, %1, %2" : "=v"(r) : "v"(lo), "v"(hi)); return r; }
template <class Epi, class Sched, bool ALIGN_EPI = false, bool SP2 = false>
__device__ __forceinline__ void gemm_phase(PG8_LAS unsigned char* lds, const Gemm g, const Sched& S, const Epi& E, int tid_in) {
    int tid_ = tid_in; asm volatile("" : "+v"(tid_));
    const int tid = tid_, wid = __builtin_amdgcn_readfirstlane(tid >> 6), lane = tid & 63, wr = wid >> 2, wc = wid & 3, fr = lane & 15, fq = lane >> 4;
    const int K = g.K, nt = K / BK;
    unsigned voffA[2], voffB[2];
#pragma unroll
    for (int i = 0; i < 2; ++i) { int R, C; stage_rc(tid * 16 + i * 8192, R, C); const int Rb = Epi::PERM ? ((R & ~31) + perm32(R & 31)) : R;
        voffA[i] = (unsigned)(R * g.lda + C) * 2u; voffB[i] = (unsigned)(Rb * g.ldb + C) * 2u; }
    const size_t kstep = (size_t)(BK * 2);
    const size_t hstepA = (size_t)HALF * g.lda * 2, hstepB = (size_t)HALF * g.ldb * 2;
    const size_t tstepA = 2 * hstepA, tstepB = 2 * hstepB;
    const unsigned ldsw = (unsigned)wid * 1024u;
    const int aoff = lds_byte(wr * 64 + fr, fq * 8), boff = lds_byte(wc * 32 + fr, fq * 8);
#define PG8_SA(b, h) (((b) * 2 + (h)) * HTB)
#define PG8_SB(b, h) ((4 + (b) * 2 + (h)) * HTB)
#define PG8_STAGE(bufoff, gbase, voff) do { _Pragma("unroll") for (int _i = 0; _i < 2; ++_i) { unsigned _v = (voff)[_i]; asm volatile("" : "+v"(_v)); \
        __builtin_amdgcn_global_load_lds((const unsigned*)((const char*)(gbase) + _v), (PG8_LAS unsigned*)(lds + (bufoff) + ldsw + _i * 8192), 16, 0, 0); } } while (0)
#define PG8_LDA(dst, b, h) do { _Pragma("unroll") for (int m = 0; m < 4; ++m) _Pragma("unroll") for (int k = 0; k < 2; ++k) dst[m][k] = *(const PG8_LAS bf16x8*)(lds + PG8_SA(b, h) + aoff + m * 2048 + k * 1024); } while (0)
#define PG8_LDB(dst, b, h) do { _Pragma("unroll") for (int n = 0; n < 2; ++n) _Pragma("unroll") for (int k = 0; k < 2; ++k) dst[n][k] = *(const PG8_LAS bf16x8*)(lds + PG8_SB(b, h) + boff + n * 2048 + k * 1024); } while (0)
#define PG8_MMA(ai, bj, At, Bt) do { __builtin_amdgcn_s_setprio(1); _Pragma("unroll") for (int m = 0; m < 4; ++m) _Pragma("unroll") for (int n = 0; n < 2; ++n) _Pragma("unroll") for (int k = 0; k < 2; ++k) \
        acc[ai][bj][m][n] = __builtin_amdgcn_mfma_f32_16x16x32_bf16(Bt[n][k], At[m][k], acc[ai][bj][m][n], 0, 0, 0); __builtin_amdgcn_s_setprio(0); } while (0)
#define PG8_WAIT_V(n) asm volatile("s_waitcnt vmcnt(" #n ")" ::: "memory")
#define PG8_WAIT_L(n) asm volatile("s_waitcnt lgkmcnt(" #n ")" ::: "memory")
#define PG8_BAR __builtin_amdgcn_s_barrier()
#define PG8_SCHED __builtin_amdgcn_sched_barrier(0)
    Unit cur, nxt; int ui = 0;
    if (!S.next(0, cur)) return;
    f32x4 acc[2][2][4][2];
#pragma unroll
    for (int a = 0; a < 2; ++a)
#pragma unroll
        for (int b = 0; b < 2; ++b)
#pragma unroll
            for (int m = 0; m < 4; ++m)
#pragma unroll
                for (int n = 0; n < 2; ++n) acc[a][b][m][n] = zero4();
    bf16x8 At[4][2], B0[2][2], B1[2][2];
    const char* cA = (const char*)g.A + (size_t)cur.pm * tstepA + cur.ka; const char* cB = (const char*)g.Bt + (size_t)cur.pn * tstepB + cur.kb;
    S.a_ready(cur);
    if constexpr (SP2) {
        PG8_STAGE(PG8_SB(0, 0), cB, voffB); PG8_STAGE(PG8_SB(0, 1), cB + hstepB, voffB); PG8_STAGE(PG8_SA(0, 0), cA, voffA); PG8_STAGE(PG8_SA(0, 1), cA + hstepA, voffA);
        if (wr == 1) PG8_BAR;
        PG8_WAIT_V(2); PG8_BAR;
        PG8_STAGE(PG8_SB(1, 0), cB + kstep, voffB); PG8_STAGE(PG8_SA(1, 0), cA + kstep, voffA); PG8_STAGE(PG8_SB(1, 1), cB + hstepB + kstep, voffB);
        PG8_WAIT_V(6); PG8_BAR;
    } else {
        PG8_STAGE(PG8_SB(0, 0), cB, voffB); PG8_STAGE(PG8_SA(0, 0), cA, voffA); PG8_STAGE(PG8_SB(0, 1), cB + hstepB, voffB); PG8_STAGE(PG8_SA(0, 1), cA + hstepA, voffA);
        if (wr == 1) PG8_BAR;
        PG8_WAIT_V(4); PG8_BAR;
        PG8_STAGE(PG8_SB(1, 0), cB + kstep, voffB); PG8_STAGE(PG8_SA(1, 0), cA + kstep, voffA); PG8_STAGE(PG8_SB(1, 1), cB + hstepB + kstep, voffB);
        PG8_WAIT_V(6); PG8_BAR;
    }
    for (;;) {
        const bool has_next = S.next(ui + 1, nxt);
        const char* nA = has_next ? (const char*)g.A + (size_t)nxt.pm * tstepA + nxt.ka : cA; const char* nB = has_next ? (const char*)g.Bt + (size_t)nxt.pn * tstepB + nxt.kb : cB;
        for (int t = 0; t < nt; t += 2) {
            const bool last = (t == nt - 2);
            const char* a1 = cA + (size_t)(t + 1) * kstep;
            const char* a2 = last ? nA : cA + (size_t)(t + 2) * kstep; const char* b2 = last ? nB : cB + (size_t)(t + 2) * kstep;
            const char* a3 = a2 + kstep; const char* b3 = b2 + kstep;
            if (last && has_next) S.a_ready(nxt);
            if constexpr (SP2) {
            PG8_LDB(B0, 0, 0); PG8_LDB(B1, 0, 1); PG8_SCHED; PG8_LDA(At, 0, 0); PG8_STAGE(PG8_SA(1, 1), a1 + hstepA, voffA);
            PG8_WAIT_V(8); PG8_WAIT_L(0); PG8_BAR; PG8_MMA(0, 0, At, B0); PG8_MMA(0, 1, At, B1); PG8_BAR; PG8_SCHED;
            PG8_LDA(At, 0, 1); PG8_STAGE(PG8_SB(0, 0), b2, voffB); PG8_STAGE(PG8_SB(0, 1), b2 + hstepB, voffB); PG8_STAGE(PG8_SA(0, 0), a2, voffA);
            PG8_WAIT_V(8); PG8_WAIT_L(0); PG8_BAR; PG8_MMA(1, 0, At, B0); PG8_MMA(1, 1, At, B1); PG8_BAR; PG8_SCHED;
            PG8_LDB(B0, 1, 0); PG8_LDB(B1, 1, 1); PG8_SCHED; PG8_LDA(At, 1, 0); PG8_STAGE(PG8_SA(0, 1), a2 + hstepA, voffA);
            PG8_WAIT_V(8); PG8_WAIT_L(0); PG8_BAR; PG8_MMA(0, 0, At, B0); PG8_MMA(0, 1, At, B1); PG8_BAR; PG8_SCHED;
            PG8_LDA(At, 1, 1); PG8_STAGE(PG8_SB(1, 0), b3, voffB); PG8_STAGE(PG8_SB(1, 1), b3 + hstepB, voffB); PG8_STAGE(PG8_SA(1, 0), a3, voffA);
            PG8_WAIT_V(8); PG8_WAIT_L(0); PG8_BAR; PG8_MMA(1, 0, At, B0); PG8_MMA(1, 1, At, B1); PG8_BAR; PG8_SCHED;
            } else {
            PG8_LDB(B0, 0, 0); PG8_SCHED; PG8_LDA(At, 0, 0); PG8_STAGE(PG8_SA(1, 1), a1 + hstepA, voffA);
            PG8_WAIT_L(8); PG8_BAR; PG8_WAIT_L(0); PG8_MMA(0, 0, At, B0); PG8_BAR; PG8_SCHED;
            PG8_LDB(B1, 0, 1); PG8_STAGE(PG8_SB(0, 0), b2, voffB);
            PG8_BAR; PG8_WAIT_L(0); PG8_MMA(0, 1, At, B1); PG8_BAR;
            PG8_LDA(At, 0, 1); PG8_STAGE(PG8_SA(0, 0), a2, voffA);
            PG8_BAR; PG8_WAIT_L(0); PG8_MMA(1, 0, At, B0); PG8_BAR; PG8_SCHED;
            PG8_STAGE(PG8_SB(0, 1), b2 + hstepB, voffB);
            PG8_WAIT_V(6); PG8_BAR; PG8_MMA(1, 1, At, B1); PG8_BAR;
            PG8_LDB(B0, 1, 0); PG8_SCHED; PG8_LDA(At, 1, 0); PG8_STAGE(PG8_SA(0, 1), a2 + hstepA, voffA);
            PG8_WAIT_L(8); PG8_BAR; PG8_WAIT_L(0); PG8_MMA(0, 0, At, B0); PG8_BAR; PG8_SCHED;
            PG8_LDB(B1, 1, 1); PG8_STAGE(PG8_SB(1, 0), b3, voffB);
            PG8_BAR; PG8_WAIT_L(0); PG8_MMA(0, 1, At, B1); PG8_BAR;
            PG8_LDA(At, 1, 1); PG8_STAGE(PG8_SA(1, 0), a3, voffA);
            PG8_BAR; PG8_WAIT_L(0); PG8_MMA(1, 0, At, B0); PG8_BAR; PG8_SCHED;
            PG8_STAGE(PG8_SB(1, 1), b3 + hstepB, voffB);
            PG8_WAIT_V(6); PG8_BAR; PG8_MMA(1, 1, At, B1); PG8_BAR;
            }
        }
        if constexpr (ALIGN_EPI) { if (wr == 0) PG8_BAR; }
        if constexpr (!Epi::AFTER_DRAIN) { E(acc, cur, wr, wc, fr, fq); S.done(cur); }
        if (!has_next) break;
#pragma unroll
        for (int a = 0; a < 2; ++a)
#pragma unroll
            for (int b = 0; b < 2; ++b)
#pragma unroll
                for (int m = 0; m < 4; ++m)
#pragma unroll
                    for (int n = 0; n < 2; ++n) acc[a][b][m][n] = zero4();
        cur = nxt; cA = nA; cB = nB; ++ui;
        if constexpr (ALIGN_EPI) { if (wr == 1) PG8_BAR; }
    }
    PG8_WAIT_V(0);
    if constexpr (!ALIGN_EPI) { if (wr == 0) PG8_BAR; }
    PG8_BAR;
    if constexpr (Epi::AFTER_DRAIN) { E.fused(acc, cur, wr, wc, fr, fq, lds, wid, lane); S.done(cur); }
#undef PG8_SA
#undef PG8_SB
#undef PG8_STAGE
#undef PG8_LDA
#undef PG8_LDB
#undef PG8_MMA
#undef PG8_WAIT_V
#undef PG8_WAIT_L
#undef PG8_BAR
#undef PG8_SCHED
}
}

typedef unsigned short bf16_t;
typedef short bf16x8 __attribute__((ext_vector_type(8)));
typedef float f32x4 __attribute__((ext_vector_type(4)));
typedef float f32x2 __attribute__((ext_vector_type(2)));
typedef unsigned u32x4 __attribute__((ext_vector_type(4)));
typedef unsigned u32x2 __attribute__((ext_vector_type(2)));
typedef _Float16 h16x8 __attribute__((ext_vector_type(8)));
#define LAS __attribute__((address_space(3)))

constexpr int NTOK = 16384, T = 8192, DM = 1024, DFF = 2816, NWAVES = 8, NTHREADS = 512;
constexpr int NWIN = 4608;
constexpr size_t MiB = 1u << 20;
constexpr size_t WS_WGU1 = 0, WS_WD1 = 11 * MiB, WS_WGU2 = 17 * MiB, WS_WD2 = 28 * MiB, WS_WIN = 34 * MiB, WS_WC1 = 43 * MiB,
                 WS_WBP = 45 * MiB, WS_WBN = 46 * MiB, WS_WO = 48 * MiB, WS_PW = 50 * MiB, WS_POSB = 51 * MiB,
                 WS_HN = 52 * MiB, WS_BIG = 84 * MiB, WS_Q = 84 * MiB, WS_GM = 116 * MiB, WS_KV = 180 * MiB, WS_GN = 204 * MiB,
                 WS_U = 207 * MiB, WS_OPOOL = 223 * MiB, WS_HID = 239 * MiB, WS_KCMP = 243 * MiB, WS_VCMPT = 243 * MiB + 256 * 1024;
constexpr size_t WS_CNT = 244 * MiB + 16384;
constexpr size_t WS_BAR = 244 * MiB;
constexpr size_t KVT = (size_t)4 * 8192 * 64;
constexpr int LDS_BYTES = 143360;
constexpr int NPH_LAYER = 13, NPHASES = 2 * NPH_LAYER + 1;
constexpr float LOG2E = 1.4426950408889634f;
#ifndef ATT_NP
#define ATT_NP 2
#endif
#ifndef PROBE_MASK
#define PROBE_MASK 0
#endif
#ifndef SYNC_REPS
#define SYNC_REPS 1
#endif
#ifndef PHMASK
#define PHMASK 0x1fff
#endif

__device__ __forceinline__ int lane_id_volatile() { int l; asm volatile("v_mbcnt_lo_u32_b32 %0, -1, 0\n\tv_mbcnt_hi_u32_b32 %0, -1, %0" : "=v"(l)); return l; }
__device__ __forceinline__ unsigned f2bf(float f) { unsigned u = __builtin_bit_cast(unsigned, f); return (u + 0x7fffu + ((u >> 16) & 1u)) >> 16; }
__device__ __forceinline__ unsigned pk2(float lo, float hi) { return pg8::cvt_pk_bf16(lo, hi); }
__device__ __forceinline__ float bflo(unsigned w) { return __builtin_bit_cast(float, w << 16); }
__device__ __forceinline__ float bfhi(unsigned w) { return __builtin_bit_cast(float, w & 0xffff0000u); }
__device__ __forceinline__ float sigmoidf_(float x) { return 1.f / (1.f + __expf(-x)); }
__device__ __forceinline__ float sigmoid_fast(float x) { return __builtin_amdgcn_rcpf(1.f + __builtin_amdgcn_exp2f(x * -1.4426950408889634f)); }
__device__ __forceinline__ float shx(float v, int mask, int lane) { return __builtin_bit_cast(float, __builtin_amdgcn_ds_bpermute((lane ^ mask) << 2, __builtin_bit_cast(int, v))); }
__device__ __forceinline__ float wave_sum(float v, int lane) {
#pragma unroll
    for (int o = 1; o < 64; o <<= 1) v += shx(v, o, lane);
    return v;
}


struct EpiGU {
    static constexpr bool PERM = true, AFTER_DRAIN = false;
    bf16_t* O;
    __device__ __forceinline__ void operator()(const f32x4 (&acc)[2][2][4][2], const pg8::Unit& u, int wr, int wc, int, int) const {
        const int ln_ = lane_id_volatile(), fr = ln_ & 15, fq = ln_ >> 4;
        const int row0 = u.pm * 256 + wr * 64 + fr, col0 = u.pn * 128 + wc * 32 + 8 * fq;
#pragma unroll
        for (int ai = 0; ai < 2; ++ai)
#pragma unroll
            for (int m = 0; m < 4; ++m) {
                float r[8];
#pragma unroll
                for (int n = 0; n < 2; ++n)
#pragma unroll
                    for (int i = 0; i < 4; ++i) { const float g = acc[ai][0][m][n][i], up = acc[ai][1][m][n][i]; r[4 * n + i] = g * sigmoid_fast(g) * up; }
                u32x4 w; w.x = pk2(r[0], r[1]); w.y = pk2(r[2], r[3]); w.z = pk2(r[4], r[5]); w.w = pk2(r[6], r[7]);
                *(u32x4*)(O + (size_t)(row0 + ai * 128 + m * 16) * DFF + col0) = w;
            }
    }
};
struct EpiResid {
    static constexpr bool PERM = false, AFTER_DRAIN = false;
    const float* xin; float* xout; float s;
    __device__ __forceinline__ void operator()(const f32x4 (&acc)[2][2][4][2], const pg8::Unit& u, int wr, int wc, int, int) const {
        const int ln_ = lane_id_volatile(), fr = ln_ & 15, fq = ln_ >> 4;
        const int row0 = u.pm * 256 + wr * 64 + fr, col0 = u.pn * 256 + wc * 32 + 4 * fq;
#pragma unroll
        for (int ai = 0; ai < 2; ++ai)
#pragma unroll
            for (int m = 0; m < 4; ++m) {
                const size_t ro = (size_t)(row0 + ai * 128 + m * 16) * DM + col0;
#pragma unroll
                for (int bj = 0; bj < 2; ++bj)
#pragma unroll
                    for (int n = 0; n < 2; ++n) { const f32x4 xi = *(const f32x4*)(xin + ro + bj * 128 + n * 16); *(f32x4*)(xout + ro + bj * 128 + n * 16) = xi + acc[ai][bj][m][n] * s; }
                asm volatile("" ::: "memory");
            }
    }
};
struct EpiSplitK {
    static constexpr bool PERM = false, AFTER_DRAIN = false;
    float* P;
    __device__ __forceinline__ void operator()(const f32x4 (&acc)[2][2][4][2], const pg8::Unit& u, int wr, int wc, int, int) const {
        const int ln_ = lane_id_volatile(), fr = ln_ & 15, fq = ln_ >> 4;
        int fr_ = fr, fq_ = fq; asm volatile("" : "+v"(fr_), "+v"(fq_));
        const int row0 = u.pm * 256 + wr * 64 + fr_, col0 = wc * 32 + 4 * fq_;
        float* base = P + (size_t)(u.ka >> 9) * (4096 * 256);
#pragma unroll
        for (int ai = 0; ai < 2; ++ai)
#pragma unroll
            for (int m = 0; m < 4; ++m) {
                float* rp = base + (size_t)(row0 + ai * 128 + m * 16) * 256 + col0;
#pragma unroll
                for (int bj = 0; bj < 2; ++bj)
#pragma unroll
                    for (int n = 0; n < 2; ++n) *(f32x4*)(rp + bj * 128 + n * 16) = acc[ai][bj][m][n];
            }
    }
};
template <int STAGE> struct EpiMerge {
    static constexpr bool PERM = true, AFTER_DRAIN = false;
    bf16_t* mg; const _Float16* gm;
    __device__ __forceinline__ void operator()(const f32x4 (&acc)[2][2][4][2], const pg8::Unit& u, int wr, int wc, int, int) const {
        const int ln_ = lane_id_volatile(), fr = ln_ & 15, fq = ln_ >> 4;
        const int row0 = u.pm * 256 + wr * 64 + fr, col0 = u.pn * 256 + wc * 32 + 8 * fq;
#pragma unroll
        for (int ai = 0; ai < 2; ++ai)
#pragma unroll
            for (int m = 0; m < 4; ++m) {
                const int row = row0 + ai * 128 + m * 16;
#pragma unroll
                for (int bj = 0; bj < 2; ++bj) {
                    const int col = col0 + bj * 128;
                    const h16x8 gv = *(const h16x8*)(gm + (size_t)row * 2048 + STAGE * 1024 + col);
                    float r[8];
#pragma unroll
                    for (int n = 0; n < 2; ++n)
#pragma unroll
                        for (int i = 0; i < 4; ++i) r[4 * n + i] = (float)gv[4 * n + i] * acc[ai][bj][m][n][i];
                    bf16_t* op = mg + (size_t)row * DM + col;
                    if (STAGE == 1) { const u32x4 pv = *(const u32x4*)op;
                        r[0] += bflo(pv.x); r[1] += bfhi(pv.x); r[2] += bflo(pv.y); r[3] += bfhi(pv.y); r[4] += bflo(pv.z); r[5] += bfhi(pv.z); r[6] += bflo(pv.w); r[7] += bfhi(pv.w); }
                    u32x4 w; w.x = pk2(r[0], r[1]); w.y = pk2(r[2], r[3]); w.z = pk2(r[4], r[5]); w.w = pk2(r[6], r[7]);
                    *(u32x4*)op = w;
                    asm volatile("" ::: "memory");
                }
            }
    }
};
struct EpiWin {
    static constexpr bool PERM = true, AFTER_DRAIN = false;
    bf16_t* q; bf16_t* kv; float* gn; bf16_t* up; _Float16* gm;
    __device__ __forceinline__ void operator()(const f32x4 (&acc)[2][2][4][2], const pg8::Unit& u, int wr, int wc, int, int) const {
        const int ln_ = lane_id_volatile(), fr = ln_ & 15, fq = ln_ >> 4;
        const int pn = u.pn;
        const int row0 = u.pm * 256 + wr * 64 + fr, cin0 = wc * 32 + 8 * fq;
#pragma unroll
        for (int ai = 0; ai < 2; ++ai)
#pragma unroll
            for (int m = 0; m < 4; ++m) {
                const int row = row0 + ai * 128 + m * 16;
#pragma unroll
                for (int bj = 0; bj < 2; ++bj) {
                    const int cin = cin0 + bj * 128;
                    float r[8];
#pragma unroll
                    for (int n = 0; n < 2; ++n)
#pragma unroll
                        for (int i = 0; i < 4; ++i) r[4 * n + i] = acc[ai][bj][m][n][i];
                    if (pn < 4) {
                        u32x4 w; constexpr float QS_ = 0.18033688011112042f;
                        w.x = pk2(r[0] * QS_, r[1] * QS_); w.y = pk2(r[2] * QS_, r[3] * QS_); w.z = pk2(r[4] * QS_, r[5] * QS_); w.w = pk2(r[6] * QS_, r[7] * QS_);
                        *(u32x4*)(q + (size_t)row * DM + pn * 256 + cin) = w;
                    } else if (pn < 7) {
                        const int ti = (pn - 4) * 2 + bj, g = wc >> 1, d0 = 32 * (wc & 1) + 8 * fq, b = row >> 13, t = row & 8191;
                        bf16_t* base = kv + (size_t)ti * KVT;
                        if (ti == 3 || ti == 5) {
                            bf16_t* vb = base + ((size_t)((b * 2 + g) * 128 + (t >> 6)) * 2 + ((t & 63) >> 5)) * 2048 + (t & 31);
#pragma unroll
                            for (int e = 0; e < 8; ++e) vb[(d0 + e) * 32] = (bf16_t)f2bf(r[e]);
                        } else {
                            u32x4 w; w.x = pk2(r[0], r[1]); w.y = pk2(r[2], r[3]); w.z = pk2(r[4], r[5]); w.w = pk2(r[6], r[7]);
                            if (ti < 2) *(u32x4*)(base + ((size_t)((b * 2 + g) * 8192 + t)) * 64 + d0) = w;
                            else *(u32x4*)(base + ((size_t)((b * 2 + g) * 128 + (t >> 6)) * 2 + (d0 >> 5)) * 2048 + (t & 63) * 32 + (d0 & 31)) = w;
                        }
                    } else if (pn < 9) {
                        u32x4 w; w.x = pk2(r[0], r[1]); w.y = pk2(r[2], r[3]); w.z = pk2(r[4], r[5]); w.w = pk2(r[6], r[7]);
                        *(u32x4*)(up + (size_t)row * 512 + (pn - 7) * 256 + cin) = w;
                    } else if (pn < 17) {
                        h16x8 hv;
#pragma unroll
                        for (int e = 0; e < 8; ++e) hv[e] = (_Float16)sigmoid_fast(r[e]);
                        *(h16x8*)(gm + (size_t)row * 2048 + (pn - 9) * 256 + cin) = hv;
                    } else {
                        if (cin < 48) {
#pragma unroll
                            for (int e = 0; e < 8; ++e) gn[(size_t)row * 48 + cin + e] = sigmoidf_(r[e]);
                        }
                    }
                    asm volatile("" ::: "memory");
                }
            }
    }
};
struct CmpOrder {
    int G, c;
    __device__ bool next(int i, pg8::Unit& u) const {
        const int L = i * G + c; if (L >= 128) return false;
        u.pm = L >> 3; u.pn = u.pm >> 3; const int kc = L & 7; u.ka = (long)kc * 512; u.kb = (long)kc * 512; return true;
    }
    __device__ __forceinline__ void a_ready(const pg8::Unit&) const {}
    __device__ __forceinline__ void done(const pg8::Unit&) const {}
};

enum { MAP_PLAIN = 0, MAP_GU = 1, MAP_WIN = 2, MAP_C1 = 3 };
template <int MAP>
__device__ __forceinline__ void cvt_item(const float* s0, const float* s1, int ldsrc, int K, bf16_t* dst, int kb, int nb, float* scr, int lane) {
    const int k0 = 64 * kb, R0 = 32 * nb, n = lane & 31, R = R0 + n;
    const float* src = s0; int col = R;
    if (MAP == MAP_GU) { const int pn = R >> 8, bj = (R >> 7) & 1, j = R & 127; src = bj ? s1 : s0; col = 128 * pn + j; }
    if (MAP == MAP_WIN) { if (R < 1792) col = R; else if (R < 2304) col = 1840 + (R - 1792); else if (R < 4352) col = 2352 + (R - 2304); else if (R < 4400) col = 1792 + (R - 4352); else col = -1; }
    if (MAP == MAP_C1) { if (R >= 256) { src = s1; col = R - 256; } }
    float ld_[32];
    const float* sp_ = src + (size_t)(k0 + (lane >> 5)) * ldsrc + (col >= 0 ? col : 0);
#pragma unroll
    for (int i = 0; i < 32; ++i) ld_[i] = __builtin_nontemporal_load(sp_ + (size_t)(2 * i) * ldsrc);
#pragma unroll
    for (int i = 0; i < 32; ++i) { const int kk = 2 * i + (lane >> 5); scr[kk * 33 + n] = (col >= 0) ? ld_[i] : 0.f; }
    __builtin_amdgcn_fence(__ATOMIC_RELEASE, "wavefront"); __builtin_amdgcn_wave_barrier();
    const int c = lane & 7;
#pragma unroll
    for (int j = 0; j < 4; ++j) { const int nn = (lane >> 3) + 8 * j; const float* s = scr + (8 * c) * 33 + nn;
        u32x4 o; o.x = pk2(s[0 * 33], s[1 * 33]); o.y = pk2(s[2 * 33], s[3 * 33]); o.z = pk2(s[4 * 33], s[5 * 33]); o.w = pk2(s[6 * 33], s[7 * 33]);
        *(u32x4*)(dst + (size_t)(R0 + nn) * K + k0 + 8 * c) = o; }
    __builtin_amdgcn_fence(__ATOMIC_RELEASE, "wavefront"); __builtin_amdgcn_wave_barrier();
}

__device__ __forceinline__ void rms_row_bf16(const float* xrow, const float* gain, bf16_t* orow, int lane) {
    const f32x4* xr = (const f32x4*)xrow + lane; const f32x4* gr = (const f32x4*)gain + lane;
    f32x4 v[4]; float s = 0.f;
#pragma unroll
    for (int j = 0; j < 4; ++j) { v[j] = xr[64 * j]; s += (v[j].x * v[j].x + v[j].y * v[j].y) + (v[j].z * v[j].z + v[j].w * v[j].w); }
    const float r = 1.f / sqrtf(wave_sum(s, lane) * (1.f / DM) + 1e-6f);
    u32x2* o8 = (u32x2*)orow + lane;
#pragma unroll
    for (int j = 0; j < 4; ++j) { const f32x4 g = gr[64 * j]; u32x2 w; w.x = pk2(v[j].x * r * g.x, v[j].y * r * g.y); w.y = pk2(v[j].z * r * g.z, v[j].w * r * g.w); o8[64 * j] = w; }
}
__device__ __forceinline__ void rms_row_f32(const float* xrow, const float* gain, float* orow, int lane) {
    const f32x4* xr = (const f32x4*)xrow + lane; const f32x4* gr = (const f32x4*)gain + lane;
    f32x4 v[4]; float s = 0.f;
#pragma unroll
    for (int j = 0; j < 4; ++j) { v[j] = xr[64 * j]; s += (v[j].x * v[j].x + v[j].y * v[j].y) + (v[j].z * v[j].z + v[j].w * v[j].w); }
    const float r = 1.f / sqrtf(wave_sum(s, lane) * (1.f / DM) + 1e-6f);
    f32x4* o = (f32x4*)orow + lane;
#pragma unroll
    for (int j = 0; j < 4; ++j) { const f32x4 g = gr[64 * j]; o[64 * j] = v[j] * r * g; }
}

template <bool F32OUT, bool WT = false>
__device__ __forceinline__ void rms_rows4(const float* x, const float* gain, void* out, int m0, int mstride, int lane) {
    f32x4 v[4][4]; float s[4];
#pragma unroll
    for (int r = 0; r < 4; ++r) { const int mr_ = m0 + r * mstride; const f32x4* xr = (const f32x4*)(x + (size_t)(mr_ < NTOK ? mr_ : m0) * DM) + lane;
#pragma unroll
        for (int j = 0; j < 4; ++j) v[r][j] = xr[64 * j]; }
#pragma unroll
    for (int r = 0; r < 4; ++r) { s[r] = 0.f;
#pragma unroll
        for (int j = 0; j < 4; ++j) s[r] += (v[r][j].x * v[r][j].x + v[r][j].y * v[r][j].y) + (v[r][j].z * v[r][j].z + v[r][j].w * v[r][j].w); }
#pragma unroll
    for (int o = 1; o < 64; o <<= 1)
#pragma unroll
        for (int r = 0; r < 4; ++r) s[r] += shx(s[r], o, lane);
    const f32x4* gr = (const f32x4*)gain + lane;
    f32x4 g[4];
#pragma unroll
    for (int j = 0; j < 4; ++j) g[j] = gr[64 * j];
#pragma unroll
    for (int r = 0; r < 4; ++r) { const int mr_ = m0 + r * mstride; if (mr_ < NTOK) { const float rr = 1.f / sqrtf(s[r] * (1.f / DM) + 1e-6f);
        if (F32OUT) { f32x4* o = (f32x4*)((float*)out + (size_t)mr_ * DM) + lane;
#pragma unroll
            for (int j = 0; j < 4; ++j) o[64 * j] = v[r][j] * rr * g[j]; }
        else { u32x2* o8 = (u32x2*)((bf16_t*)out + (size_t)mr_ * DM) + lane;
#pragma unroll
            for (int j = 0; j < 4; ++j) { u32x2 w; w.x = pk2(v[r][j].x * rr * g[j].x, v[r][j].y * rr * g[j].y); w.y = pk2(v[r][j].z * rr * g[j].z, v[r][j].w * rr * g[j].w); if (WT) __hip_atomic_store((unsigned long long*)(o8 + 64 * j), (unsigned long long)w.x | ((unsigned long long)w.y << 32), __ATOMIC_RELAXED, __HIP_MEMORY_SCOPE_AGENT);
                else o8[64 * j] = w; } } } }
}

__device__ __forceinline__ bf16x8 ld8(const bf16_t* p) { return *(const bf16x8*)p; }
template <int CTRL> __device__ __forceinline__ float dpp_f(float v) { return __builtin_bit_cast(float, __builtin_amdgcn_update_dpp(0, __builtin_bit_cast(int, v), CTRL, 0xf, 0xf, false)); }
__device__ __forceinline__ int late_head(int g) { return g * 8 + (lane_id_volatile() & 7); }
constexpr int QS = 272;

typedef unsigned v4u32_t __attribute__((ext_vector_type(4)));
struct KvSrc { __amdgpu_buffer_rsrc_t rs; const char* base; unsigned koff, voff; };
template <bool LOADV>
__device__ __forceinline__ void kv_load(const KvSrc& S, const bf16_t* __restrict__ K, const bf16_t* __restrict__ Vt, bf16x8 (&kf)[8], bf16x8 (&vf)[8]) {
    const unsigned sk = (unsigned)((const char*)K - S.base), sv = (unsigned)((const char*)Vt - S.base);
#pragma unroll
    for (int c = 0; c < 2; ++c)
#pragma unroll
        for (int a = 0; a < 2; ++a)
#pragma unroll
            for (int kk = 0; kk < 2; ++kk)
                kf[(c * 2 + a) * 2 + kk] = __builtin_bit_cast(bf16x8, __builtin_amdgcn_raw_buffer_load_b128(S.rs, S.koff + (unsigned)(c * 2048 + a * 256), sk + (unsigned)(kk * 4096), 0));
    if (LOADV) {
#pragma unroll
        for (int dd = 0; dd < 4; ++dd)
#pragma unroll
            for (int c = 0; c < 2; ++c)
                vf[dd * 2 + c] = __builtin_bit_cast(bf16x8, __builtin_amdgcn_raw_buffer_load_b128(S.rs, S.voff + (unsigned)(dd * 1024), sv + (unsigned)(c * 4096), 0));
    }
}

template <int MODE, int KSTEP>
__device__ __forceinline__ void grp_compute(const bf16x8 (&kf)[8], const bf16x8 (&vf)[8], const bf16x8 (&qf)[2], float sl2, int dl, unsigned wlimit, bool lanesel, bool need_mask,
                                            float& m, float& l, f32x4 (&o)[4], float mfix, float* scq, int jbase, int lane) {
    const int mr = lane & 15, kq = lane >> 4;
    const float bl = -sl2 * (float)dl, slk = sl2 * (float)KSTEP;
    f32x4 s[2][2];
#pragma unroll
    for (int c = 0; c < 2; ++c)
#pragma unroll
        for (int a = 0; a < 2; ++a) {
            f32x4 z;
#pragma unroll
            for (int i = 0; i < 4; ++i) z[i] = __builtin_fmaf((float)(32 * c + 4 * a + i), slk, bl);
            z = __builtin_amdgcn_mfma_f32_16x16x32_bf16(kf[(c * 2 + a) * 2 + 0], qf[0], z, 0, 0, 0);
            s[c][a] = __builtin_amdgcn_mfma_f32_16x16x32_bf16(kf[(c * 2 + a) * 2 + 1], qf[1], z, 0, 0, 0);
        }
    if (need_mask) {
#pragma unroll
        for (int c = 0; c < 2; ++c)
#pragma unroll
            for (int a = 0; a < 2; ++a)
#pragma unroll
                for (int i = 0; i < 4; ++i) { const unsigned d = (unsigned)(dl - (32 * c + 4 * a + i) * KSTEP); const bool v = lanesel && (d < wlimit); s[c][a][i] = v ? s[c][a][i] : -1e30f; }
    }
    float bm = -1e30f;
#pragma unroll
    for (int c = 0; c < 2; ++c)
#pragma unroll
        for (int a = 0; a < 2; ++a)
#pragma unroll
            for (int i = 0; i < 4; ++i) bm = fmaxf(bm, s[c][a][i]);
    float sh;
    if (MODE != 2) {
        if (__ballot(bm > m + 16.f) != 0ull) {
            bm = fmaxf(bm, shx(bm, 16, lane)); bm = fmaxf(bm, shx(bm, 32, lane)); const float mn = fmaxf(fmaxf(m, bm), -1e29f);
            const float alpha = __builtin_amdgcn_exp2f(m - mn); m = mn; l = l * alpha;
            if (MODE == 0) {
#pragma unroll
                for (int dd = 0; dd < 4; ++dd) o[dd] = o[dd] * alpha; }
        }
        sh = m;
    } else sh = mfix;
    float ps = 0.f;
#pragma unroll
    for (int c = 0; c < 2; ++c)
#pragma unroll
        for (int a = 0; a < 2; ++a)
#pragma unroll
            for (int i = 0; i < 4; ++i) { const float p = __builtin_amdgcn_exp2f(s[c][a][i] - sh); s[c][a][i] = p; ps += p; }
    if (MODE != 2) l += ps;
    if (MODE != 1) {
#pragma unroll
        for (int c = 0; c < 2; ++c) {
            u32x4 w; w.x = pk2(s[c][0][0], s[c][0][1]); w.y = pk2(s[c][0][2], s[c][0][3]); w.z = pk2(s[c][1][0], s[c][1][1]); w.w = pk2(s[c][1][2], s[c][1][3]);
            const bf16x8 pb = __builtin_bit_cast(bf16x8, w);
#pragma unroll
            for (int dd = 0; dd < 4; ++dd) o[dd] = __builtin_amdgcn_mfma_f32_16x16x32_bf16(vf[dd * 2 + c], pb, o[dd], 0, 0, 0);
        }
    }
    if (MODE == 2) {
#pragma unroll
        for (int c = 0; c < 2; ++c)
#pragma unroll
            for (int a = 0; a < 2; ++a) {
                float h[4];
#pragma unroll
                for (int i = 0; i < 4; ++i) { float v = s[c][a][i]; v += dpp_f<0xB1>(v); v += dpp_f<0x4E>(v); v += dpp_f<0x141>(v); h[i] = v; }
                if ((mr & 7) == 0) { const int j = jbase + 8 * c + 2 * kq + a; scq[j] = h[0] + h[1] + h[2] + 0.5f * h[3]; scq[128 + j + 1] = 0.5f * h[3]; }
            }
    }
}

template <int NP>
__device__ __forceinline__ void attn_item(int bg, int t0, const bf16_t* q, const bf16_t* kvb, const bf16_t* kcmp, const bf16_t* vcmpT, const float* gn, bf16_t* onsa, float* wl  , int lane) {
    constexpr int NQ = 2 * NP;
    const int b = bg >> 1, g = bg & 1, col = lane & 15, kq = lane >> 4, head = g * 8 + (col & 7), qsub = col >> 3;
    const float sl2 = __builtin_amdgcn_exp2f(-0.5f * (float)(head + 1)) * LOG2E;
    int tq[NP];
    bf16x8* qfL = (bf16x8*)(wl + 2 * NP * QS + NP * 4 * 64 * 4) + lane;
    f32x4* totL = (f32x4*)(wl + 2 * NP * QS) + lane;
#pragma unroll
    for (int gi = 0; gi < NP; ++gi) {
        tq[gi] = t0 + 2 * gi + qsub; const size_t row = (size_t)b * T + tq[gi];
        qfL[(gi * 2 + 0) * 64] = ld8(q + row * DM + head * 64 + kq * 8); qfL[(gi * 2 + 1) * 64] = ld8(q + row * DM + head * 64 + 32 + kq * 8);
    }
    KvSrc KS; KS.base = (const char*)kvb; KS.rs = __builtin_amdgcn_make_buffer_rsrc((void*)kvb, (short)0, (int)(WS_VCMPT + 262144 - WS_KV), 0x00020000);
    { const int mr_ = lane & 15; KS.koff = (unsigned)(((8 * (mr_ >> 2) + (mr_ & 3)) * 32 + kq * 8) * 2); KS.voff = (unsigned)((mr_ * 32 + 8 * kq) * 2); }
#pragma unroll
    for (int qi = 0; qi < NQ; ++qi) { float* s_ = wl + qi * QS; s_[lane] = 0.f; s_[lane + 64] = 0.f; s_[128 + lane] = 0.f; s_[192 + lane] = 0.f; if (lane == 0) s_[256] = 0.f; }
    __builtin_amdgcn_fence(__ATOMIC_RELEASE, "wavefront"); __builtin_amdgcn_wave_barrier();
    const int tmax = t0 + NQ - 1;
    const int nv = (tmax >= 31) ? ((tmax - 31) >> 4) + 1 : 0, ncb = (nv + 63) >> 6;
    const int nfull = (t0 >= 31) ? ((((t0 - 31) >> 4) + 1) >> 6) : 0;
    bf16x8 kfA[8], vfA[8], kfB[8], vfB[8];
    {
        const bf16_t* Kc = kcmp + (size_t)bg * 512 * 64; const bf16_t* Vc = vcmpT + (size_t)bg * 512 * 64;
        float m[NP], l[NP], invl[NP]; f32x4 o[NP][4];
#pragma unroll
        for (int gi = 0; gi < NP; ++gi) { m[gi] = -1e29f; l[gi] = 0.f;
#pragma unroll
            for (int dd = 0; dd < 4; ++dd) o[gi][dd] = zero4(); }
        if (ncb > 0) kv_load<false>(KS, Kc + (ncb - 1) * 4096, Vc, kfA, vfA);
        for (int jb = ncb - 1; jb >= 0; --jb) {
            if (jb > 0) kv_load<false>(KS, Kc + (jb - 1) * 4096, Vc, kfB, vfB);
#pragma unroll
            for (int gi = 0; gi < NP; ++gi) { const int dl_ = tq[gi] - (1024 * jb + 31) - 128 * kq;
                { const bf16x8 qv_[2] = {qfL[(gi * 2 + 0) * 64], qfL[(gi * 2 + 1) * 64]}; grp_compute<1, 16>(kfA, vfA, qv_, sl2, dl_, 0x40000000u, true, jb >= nfull, m[gi], l[gi], o[gi], 0.f, wl, 0, lane); } }
#pragma unroll
            for (int e = 0; e < 8; ++e) kfA[e] = kfB[e];
        }
#pragma unroll
        for (int gi = 0; gi < NP; ++gi) { float L = l[gi]; L += shx(L, 16, lane); L += shx(L, 32, lane); invl[gi] = fmaxf(m[gi], -1e29f) + __builtin_amdgcn_logf(fmaxf(L, 1e-30f)); }
        if (ncb > 0) kv_load<true>(KS, Kc, Vc, kfA, vfA);
        for (int jb = 0; jb < ncb; ++jb) {
            if (jb + 1 < ncb) kv_load<true>(KS, Kc + (jb + 1) * 4096, Vc + (jb + 1) * 4096, kfB, vfB);
#pragma unroll
            for (int gi = 0; gi < NP; ++gi) { const int dl_ = tq[gi] - (1024 * jb + 31) - 128 * kq;
                { const bf16x8 qv_[2] = {qfL[(gi * 2 + 0) * 64], qfL[(gi * 2 + 1) * 64]}; grp_compute<2, 16>(kfA, vfA, qv_, sl2, dl_, 0x40000000u, true, jb >= nfull, m[gi], l[gi], o[gi], invl[gi], wl + (2 * gi + qsub) * QS, 16 * jb, lane); } }
#pragma unroll
            for (int e = 0; e < 8; ++e) { kfA[e] = kfB[e]; vfA[e] = vfB[e]; }
        }
#pragma unroll
        for (int gi = 0; gi < NP; ++gi)
#pragma unroll
            for (int dd = 0; dd < 4; ++dd) totL[(gi * 4 + dd) * 64] = o[gi][dd] * gn[((size_t)b * T + tq[gi]) * 48 + late_head(g) * 3 + 0];
    }
    __builtin_amdgcn_fence(__ATOMIC_RELEASE, "wavefront"); __builtin_amdgcn_wave_barrier();
    const int cur = t0 >> 6;
    unsigned long long mk0[NQ], mk1[NQ];
    if (cur < 16) {
#pragma unroll
        for (int qi = 0; qi < NQ; ++qi) { mk0[qi] = (1ull << (cur + 1)) - 1ull; mk1[qi] = 0ull; }
    } else {
#pragma unroll
        for (int qi = 0; qi < NQ; ++qi) {
            const float* sc = wl + qi * QS; const float* hf = sc + 128;
            unsigned u0, u1;
            { const int j = lane; const bool val = j <= cur, forced = val && (j == 0 || j == cur || j == cur - 1); u0 = forced ? 0xFFFFFFFFu : (val ? __builtin_bit_cast(unsigned, sc[j] + hf[j]) + 1u : 0u); }
            { const int j = lane + 64; const bool val = j <= cur, forced = val && (j == cur || j == cur - 1); u1 = forced ? 0xFFFFFFFFu : (val ? __builtin_bit_cast(unsigned, sc[j] + hf[j]) + 1u : 0u); }
            unsigned thr = 0u;
            for (int bit = 31; bit >= 0; --bit) { const unsigned cand = thr | (1u << bit);
                const int cnt = __builtin_popcountll(__ballot(u0 >= cand)) + __builtin_popcountll(__ballot(u1 >= cand));
                thr = (cnt >= 16) ? cand : thr; }
            const unsigned long long gt0 = __ballot(u0 > thr), gt1 = __ballot(u1 > thr), eq0 = __ballot(u0 == thr), eq1 = __ballot(u1 == thr);
            int quota = 16 - __builtin_popcountll(gt0) - __builtin_popcountll(gt1);
            const bool t0_ = (u0 == thr) && ((int)__builtin_amdgcn_mbcnt_hi((unsigned)(eq0 >> 32), __builtin_amdgcn_mbcnt_lo((unsigned)eq0, 0u)) < quota);
            quota -= __builtin_popcountll(eq0);
            const bool t1_ = (u1 == thr) && ((int)__builtin_amdgcn_mbcnt_hi((unsigned)(eq1 >> 32), __builtin_amdgcn_mbcnt_lo((unsigned)eq1, 0u)) < quota);
            mk0[qi] = (gt0 | __ballot(t0_)) & __ballot(lane <= cur); mk1[qi] = (gt1 | __ballot(t1_)) & __ballot(lane + 64 <= cur);
        }
    }
    {
        const bf16_t* Ks = kvb + 2 * KVT + (size_t)bg * 8192 * 64; const bf16_t* Vs = kvb + 3 * KVT + (size_t)bg * 8192 * 64;
        float m[NP], l[NP]; f32x4 o[NP][4];
#pragma unroll
        for (int gi = 0; gi < NP; ++gi) { m[gi] = -1e29f; l[gi] = 0.f;
#pragma unroll
            for (int dd = 0; dd < 4; ++dd) o[gi][dd] = zero4(); }
#pragma unroll
        for (int half = 1; half >= 0; --half) {
            unsigned long long U = 0ull, ug[NP], xg[NP], ma[NP];
#pragma unroll
            for (int gi = 0; gi < NP; ++gi) { const unsigned long long a_ = half ? mk1[2 * gi] : mk0[2 * gi], b_ = half ? mk1[2 * gi + 1] : mk0[2 * gi + 1]; ug[gi] = a_ | b_; xg[gi] = a_ ^ b_; U |= ug[gi]; ma[gi] = a_; }
            if (U) { const int j = half * 64 + 63 - __builtin_clzll(U); kv_load<true>(KS, Ks + (size_t)j * 4096, Vs + (size_t)j * 4096, kfA, vfA); }
            while (U) {
                const int jl = 63 - __builtin_clzll(U), j = half * 64 + jl; U &= ~(1ull << jl);
                if (U) { const int jn = half * 64 + 63 - __builtin_clzll(U); kv_load<true>(KS, Ks + (size_t)jn * 4096, Vs + (size_t)jn * 4096, kfB, vfB); }
#pragma unroll
                for (int gi = 0; gi < NP; ++gi) if ((ug[gi] >> jl) & 1ull) { const int dl_ = tq[gi] - 64 * j - 8 * kq;
                    { const bf16x8 qv_[2] = {qfL[(gi * 2 + 0) * 64], qfL[(gi * 2 + 1) * 64]}; grp_compute<0, 1>(kfA, vfA, qv_, sl2, dl_, 0x40000000u, (((xg[gi] >> jl) & 1ull) == 0ull) || ((int)((ma[gi] >> jl) & 1ull) != qsub), !(j < cur && !((xg[gi] >> jl) & 1ull)), m[gi], l[gi], o[gi], 0.f, wl, 0, lane); } }
#pragma unroll
                for (int e = 0; e < 8; ++e) { kfA[e] = kfB[e]; vfA[e] = vfB[e]; }
            }
        }
#pragma unroll
        for (int gi = 0; gi < NP; ++gi) { float L = l[gi]; L += shx(L, 16, lane); L += shx(L, 32, lane); const float sc1 = gn[((size_t)b * T + tq[gi]) * 48 + late_head(g) * 3 + 1] / fmaxf(L, 1e-30f);
#pragma unroll
            for (int dd = 0; dd < 4; ++dd) totL[(gi * 4 + dd) * 64] = totL[(gi * 4 + dd) * 64] + o[gi][dd] * sc1; }
    }
    {
        const bf16_t* Kw = kvb + 4 * KVT + (size_t)bg * 8192 * 64; const bf16_t* Vw = kvb + 5 * KVT + (size_t)bg * 8192 * 64;
        float m[NP], l[NP]; f32x4 o[NP][4];
#pragma unroll
        for (int gi = 0; gi < NP; ++gi) { m[gi] = -1e29f; l[gi] = 0.f;
#pragma unroll
            for (int dd = 0; dd < 4; ++dd) o[gi][dd] = zero4(); }
        const int j0 = (t0 >= 511) ? ((t0 - 511) >> 6) : 0;
        kv_load<true>(KS, Kw + (size_t)cur * 4096, Vw + (size_t)cur * 4096, kfA, vfA);
        for (int j = cur; j >= j0; --j) {
            if (j > j0) kv_load<true>(KS, Kw + (size_t)(j - 1) * 4096, Vw + (size_t)(j - 1) * 4096, kfB, vfB);
#pragma unroll
            for (int gi = 0; gi < NP; ++gi) { const int dl_ = tq[gi] - 64 * j - 8 * kq;
                { const bf16x8 qv_[2] = {qfL[(gi * 2 + 0) * 64], qfL[(gi * 2 + 1) * 64]}; grp_compute<0, 1>(kfA, vfA, qv_, sl2, dl_, 512u, true, !(64 * j + 63 <= t0 && 64 * j >= tmax - 511), m[gi], l[gi], o[gi], 0.f, wl, 0, lane); } }
#pragma unroll
            for (int e = 0; e < 8; ++e) { kfA[e] = kfB[e]; vfA[e] = vfB[e]; }
        }
#pragma unroll
        for (int gi = 0; gi < NP; ++gi) { float L = l[gi]; L += shx(L, 16, lane); L += shx(L, 32, lane); const float sc2 = gn[((size_t)b * T + tq[gi]) * 48 + late_head(g) * 3 + 2] / fmaxf(L, 1e-30f);
#pragma unroll
            for (int dd = 0; dd < 4; ++dd) o[gi][dd] = totL[(gi * 4 + dd) * 64] + o[gi][dd] * sc2;
            const size_t row = (size_t)b * T + tq[gi];
#pragma unroll
            for (int dd = 0; dd < 4; ++dd) { u32x2 w; w.x = pk2(o[gi][dd][0], o[gi][dd][1]); w.y = pk2(o[gi][dd][2], o[gi][dd][3]);
                *(u32x2*)(onsa + row * DM + late_head(g) * 64 + 16 * dd + 4 * (lane_id_volatile() >> 4)) = w; } }
    }
    __builtin_amdgcn_fence(__ATOMIC_RELEASE, "wavefront"); __builtin_amdgcn_wave_barrier();
}

template <int N> __device__ __forceinline__ float ror16(float v) { return __builtin_bit_cast(float, __builtin_amdgcn_update_dpp(0, __builtin_bit_cast(int, v), 0x120 + N, 0xf, 0xf, false)); }
template <int N> __device__ __forceinline__ void pool_step(float (&c)[8], float (&p)[8], int mr) {
#pragma unroll
    for (int e = 0; e < 8; ++e) { const float rc = ror16<N>(c[e]), rp = ror16<N>(p[e]); c[e] += (mr >= N) ? rc : rp; p[e] += rp; }
}
__device__ __forceinline__ void pool_delta(const bf16_t* U, int row, int t, int gi, int kq, int mr, bf16x8 (&af)[4]) {
    const int w = 2 << gi;
    const float ic = 1.f / (float)((t + 1 < w) ? (t + 1) : w);
    const bool first = ((row - mr) & 8191) == 0;
    u32x4 cu[4], pu[4];
#pragma unroll
    for (int kk = 0; kk < 4; ++kk) { const bf16_t* up = U + (size_t)row * 512 + gi * 128 + kk * 32 + kq * 8; cu[kk] = *(const u32x4*)up; pu[kk] = first ? (u32x4){0u, 0u, 0u, 0u} : *(const u32x4*)(up - 16 * 512); }
#pragma unroll
    for (int kk = 0; kk < 4; ++kk) {
        float c[8] = {bflo(cu[kk].x), bfhi(cu[kk].x), bflo(cu[kk].y), bfhi(cu[kk].y), bflo(cu[kk].z), bfhi(cu[kk].z), bflo(cu[kk].w), bfhi(cu[kk].w)};
        float p[8] = {bflo(pu[kk].x), bfhi(pu[kk].x), bflo(pu[kk].y), bfhi(pu[kk].y), bflo(pu[kk].z), bfhi(pu[kk].z), bflo(pu[kk].w), bfhi(pu[kk].w)};
        pool_step<1>(c, p, mr);
        if (gi >= 1) pool_step<2>(c, p, mr);
        if (gi >= 2) pool_step<4>(c, p, mr);
        if (gi >= 3) pool_step<8>(c, p, mr);
        const u32x4 self = cu[kk];
        u32x4 d; d.x = pk2(c[0] * ic - bflo(self.x), c[1] * ic - bfhi(self.x)); d.y = pk2(c[2] * ic - bflo(self.y), c[3] * ic - bfhi(self.y));
        d.z = pk2(c[4] * ic - bflo(self.z), c[5] * ic - bfhi(self.z)); d.w = pk2(c[6] * ic - bflo(self.w), c[7] * ic - bfhi(self.w));
        af[kk] = __builtin_bit_cast(bf16x8, d);
    }
}

#define XB_TMO      128
#define XB_XCNT(j)  (256  + 64 * (j))
#define XB_XSUB(j)  (1280 + 64 * (j))
#define XB_XGEN(j)  (2304 + 64 * (j))
#define XB_TOP      3328
#define XB_TOPGEN   3392
#define XCD_BAR_WORDS 3456
#define XB_SPIN_CAP (1u << 18)

__device__ __forceinline__ unsigned xb_ld(unsigned* p)              { return __hip_atomic_load(p, __ATOMIC_RELAXED, __HIP_MEMORY_SCOPE_AGENT); }
__device__ __forceinline__ unsigned xb_add(unsigned* p, unsigned v) { return __hip_atomic_fetch_add(p, v, __ATOMIC_RELAXED, __HIP_MEMORY_SCOPE_AGENT); }
__device__ __forceinline__ unsigned xb_xcc_id() { return (unsigned)__builtin_amdgcn_s_getreg((3 << 11) | 20) & 0xFu; }
#define XB_SPIN(cond, bar) do { unsigned _sp = 0; while (cond) { __builtin_amdgcn_s_sleep(1); \
    if ((++_sp & 255u) == 0u) { if (xb_ld(&(bar)[XB_TMO])) break; if (_sp > XB_SPIN_CAP) { atomicAdd(&(bar)[XB_TMO], 1u); break; } } } } while (0)

struct XcdBarrier {
    unsigned* bar; unsigned x;
    volatile LAS unsigned* st;
};

__device__ __forceinline__ XcdBarrier xcd_barrier_post(unsigned* bar, volatile LAS unsigned* st) {
    XcdBarrier b; b.bar = bar; b.x = xb_xcc_id(); b.st = st;
    if (threadIdx.x == 0) (void)xb_add(&bar[XB_XCNT(b.x)], 1u);
    return b;
}
__device__ __forceinline__ void xcd_barrier_complete(unsigned* bar, unsigned x, unsigned& nloc, unsigned& nx) {
    const unsigned G = gridDim.x * gridDim.y * gridDim.z;
    unsigned sum, cnt, mine, sp = 0u;
    for (;;) {
        sum = 0u; cnt = 0u; mine = 0u;
#pragma unroll
        for (unsigned j = 0; j < 16; ++j) { const unsigned c = xb_ld(&bar[XB_XCNT(j)]); sum += c; cnt += (c > 0u) ? 1u : 0u; mine = (j == x) ? c : mine; }
        if (sum == G) break;
        __builtin_amdgcn_s_sleep(1);
        if ((++sp & 255u) == 0u) { if (xb_ld(&bar[XB_TMO])) break; if (sp > XB_SPIN_CAP) { atomicAdd(&bar[XB_TMO], 1u); break; } }
    }
    nloc = mine > 0u ? mine : 1u; nx = cnt > 0u ? cnt : 1u;
}

__device__ __forceinline__ void xcd_barrier(const XcdBarrier& b, int tid) {
    asm volatile("s_waitcnt vmcnt(0)" ::: "memory");
    __syncthreads();
    if (tid == 0) {
        unsigned* bar = b.bar;
        __builtin_amdgcn_s_waitcnt(0);
        unsigned nloc = b.st[0], nx = b.st[1];
        if (nloc == 0u) { xcd_barrier_complete(bar, b.x, nloc, nx); b.st[0] = nloc; b.st[1] = nx; }
        const unsigned old = xb_add(&bar[XB_XSUB(b.x)], 1u);
        const unsigned gen = old / nloc;
        if (old + 1u == (gen + 1u) * nloc) {
            __builtin_amdgcn_fence(__ATOMIC_RELEASE, "agent");
            asm volatile("s_waitcnt vmcnt(0)" ::: "memory");
            const unsigned og = xb_add(&bar[XB_TOP], 1u);
            const unsigned tg = og / nx;
            if (og + 1u == (tg + 1u) * nx) xb_add(&bar[XB_TOPGEN], 1u);
            else XB_SPIN(xb_ld(&bar[XB_TOPGEN]) == tg, bar);
            __builtin_amdgcn_fence(__ATOMIC_ACQUIRE, "agent");
            xb_add(&bar[XB_XGEN(b.x)], 1u);
            asm volatile("s_waitcnt vmcnt(0)" ::: "memory");
        } else {
            XB_SPIN(xb_ld(&bar[XB_TOPGEN]) == gen, bar);
            __builtin_amdgcn_fence(__ATOMIC_ACQUIRE, "agent");
            asm volatile("s_waitcnt vmcnt(0)" ::: "memory");
        }
    }
    __syncthreads();
}


struct Args { const float* in[22]; float* out; unsigned char* ws; int ph_lo, ph_hi; };

typedef const __attribute__((address_space(4))) Args* ArgsP;
__device__ __forceinline__ void convert_weights(ArgsP ap, int l, unsigned char* ws, float* scr, int lane, int wv, int nw, unsigned mask) {
    const auto& args = *ap;
    const float* wg1 = args.in[2] + (size_t)l * DM * DFF; const float* wu1 = args.in[3] + (size_t)l * DM * DFF; const float* wd1 = args.in[4] + (size_t)l * DFF * DM;
    const float* wg2 = args.in[18] + (size_t)l * DM * DFF; const float* wu2 = args.in[19] + (size_t)l * DM * DFF; const float* wd2 = args.in[20] + (size_t)l * DFF * DM;
    const float* win = args.in[6] + (size_t)l * DM * 4400;
    const float* w1k = args.in[8] + (size_t)l * 2048 * 256; const float* w1v = args.in[10] + (size_t)l * 2048 * 256;
    const float* pw = args.in[12] + (size_t)l * 4 * 128 * 128;
    const float* wbp = args.in[14] + (size_t)l * 512 * DM; const float* wbn = args.in[15] + (size_t)l * DM * DM; const float* wo = args.in[16] + (size_t)l * DM * DM;
    constexpr int I_GU = 16 * 176, I_D = 44 * 32, I_WIN = 16 * 144, I_C1 = 32 * 16, I_BP = 8 * 32, I_BN = 16 * 32, I_WO = 16 * 32, I_PW = 32;
    constexpr int NIT = 2 * I_GU + 2 * I_D + I_WIN + I_C1 + I_BP + I_BN + I_WO + I_PW;
    for (int it = wv; it < NIT; it += nw) {
        int r = it;
        if (r < I_GU) { if ((mask >> 0) & 1u) cvt_item<MAP_GU>(wg1, wu1, DFF, DM, (bf16_t*)(ws + WS_WGU1), r / 176, r % 176, scr, lane); continue; } r -= I_GU;
        if (r < I_GU) { if ((mask >> 1) & 1u) cvt_item<MAP_GU>(wg2, wu2, DFF, DM, (bf16_t*)(ws + WS_WGU2), r / 176, r % 176, scr, lane); continue; } r -= I_GU;
        if (r < I_D) { if ((mask >> 2) & 1u) cvt_item<MAP_PLAIN>(wd1, wd1, DM, DFF, (bf16_t*)(ws + WS_WD1), r / 32, r % 32, scr, lane); continue; } r -= I_D;
        if (r < I_D) { if ((mask >> 3) & 1u) cvt_item<MAP_PLAIN>(wd2, wd2, DM, DFF, (bf16_t*)(ws + WS_WD2), r / 32, r % 32, scr, lane); continue; } r -= I_D;
        if (r < I_WIN) { if ((mask >> 4) & 1u) cvt_item<MAP_WIN>(win, win, 4400, DM, (bf16_t*)(ws + WS_WIN), r / 144, r % 144, scr, lane); continue; } r -= I_WIN;
        if (r < I_C1) { if ((mask >> 5) & 1u) cvt_item<MAP_C1>(w1k, w1v, 256, 2048, (bf16_t*)(ws + WS_WC1), r / 16, r % 16, scr, lane); continue; } r -= I_C1;
        if (r < I_BP) { if ((mask >> 6) & 1u) cvt_item<MAP_PLAIN>(wbp, wbp, DM, 512, (bf16_t*)(ws + WS_WBP), r / 32, r % 32, scr, lane); continue; } r -= I_BP;
        if (r < I_BN) { if ((mask >> 7) & 1u) cvt_item<MAP_PLAIN>(wbn, wbn, DM, DM, (bf16_t*)(ws + WS_WBN), r / 32, r % 32, scr, lane); continue; } r -= I_BN;
        if (r < I_WO) { if ((mask >> 8) & 1u) cvt_item<MAP_PLAIN>(wo, wo, DM, DM, (bf16_t*)(ws + WS_WO), r / 32, r % 32, scr, lane); continue; } r -= I_WO;
        { const int gi = r >> 3, rr = r & 7; if ((mask >> 9) & 1u) cvt_item<MAP_PLAIN>(pw + gi * 16384, pw, 128, 128, (bf16_t*)(ws + WS_PW) + gi * 16384, rr >> 2, rr & 3, scr, lane); }
    }
}

__device__ __forceinline__ void run_phase(ArgsP ap, int ph, unsigned char* lds, int rep, int wave_s) {
    const auto& args = *ap;
    int bid_ = blockIdx.x; asm volatile("" : "+s"(bid_));
    const int wave = wave_s;
    const int G = gridDim.x, bid = bid_, gw = bid * NWAVES + wave, NGW = G * NWAVES;
#define PHASE_IDS const int tid = wave_s * 64 + lane_id_volatile(); const int lane = tid & 63; (void)tid; (void)lane
    unsigned char* ws = args.ws;
    PG8_LAS unsigned char* ldsl = (PG8_LAS unsigned char*)lds;
    bf16_t* HN = (bf16_t*)(ws + WS_HN); bf16_t* HFF = (bf16_t*)(ws + WS_BIG); bf16_t* Q = (bf16_t*)(ws + WS_Q); _Float16* GM = (_Float16*)(ws + WS_GM);
    bf16_t* KV = (bf16_t*)(ws + WS_KV); float* GN = (float*)(ws + WS_GN); bf16_t* U = (bf16_t*)(ws + WS_U); bf16_t* OPOOL = (bf16_t*)(ws + WS_OPOOL);
    float* HID = (float*)(ws + WS_HID); bf16_t* KCMP = (bf16_t*)(ws + WS_KCMP); bf16_t* VCMPT = (bf16_t*)(ws + WS_VCMPT); float* POSB = (float*)(ws + WS_POSB);
    bf16_t* ONSA = HN; bf16_t* MG = Q;
    float* X = args.out;
    if (ph == 2 * NPH_LAYER) {
        PHASE_IDS;
        for (int mrow = gw; mrow < NTOK; mrow += 4 * NGW) rms_rows4<true>(X, args.in[21], X, mrow, NGW, lane);
        return;
    }
    const int l = ph / NPH_LAYER, p = ph % NPH_LAYER;
    if (!((PHMASK >> p) & 1)) return;
    switch (p) {
    case 0: {
        PHASE_IDS;
        float* scr = (float*)lds + wave * (64 * 33);
        const float* w1k = args.in[8] + (size_t)l * 2048 * 256; const float* w1v = args.in[10] + (size_t)l * 2048 * 256;
        constexpr unsigned CV_A = 1u << 0, CV_B = (1u << 2) | (1u << 4) | (1u << 5) | (1u << 9), CV_C = (1u << 1) | (1u << 3) | (1u << 6) | (1u << 7) | (1u << 8);
        convert_weights(ap, l, ws, scr, lane, gw, NGW, (G == 256) ? CV_A : (CV_A | CV_B | CV_C));
        const float* xin = (l == 0) ? args.in[0] : X;
        const float* gain = args.in[1] + l * DM;
        for (int mrow = gw; mrow < NTOK; mrow += 4 * NGW) rms_rows4<false>(xin, gain, HN, mrow, NGW, lane);
        const float* pos = args.in[7] + l * 2048;
        for (int it = gw; it < 512; it += NGW) { const int kvs = it >> 8, j = it & 255; const float* w1 = kvs ? w1v : w1k; float s = 0.f;
            for (int i = 0; i < 32; ++i) { const int k = lane + 64 * i; s += pos[k] * w1[(size_t)k * 256 + j]; }
            s = wave_sum(s, lane); if (lane == 0) POSB[it] = s; }
        break; }
    case 1: case 11: {
        PHASE_IDS;
        const bool fuse_ = (p == 11 && G == 256);
        unsigned* cnt_ = (unsigned*)(ws + WS_CNT) + (size_t)(l * 2 + 1) * 64 * 64;
        if (fuse_) {
            const float* gain = args.in[17] + l * DM; const int m0 = bid * 64 + wave * 8;
            rms_rows4<false, true>(X, gain, HN, m0, 1, lane); rms_rows4<false, true>(X, gain, HN, m0 + 4, 1, lane);
            asm volatile("s_waitcnt vmcnt(0)" ::: "memory"); __syncthreads();
            if (tid == 0) { (void)__hip_atomic_fetch_add(cnt_ + (bid >> 2) * 64, 1u, __ATOMIC_RELAXED, __HIP_MEMORY_SCOPE_AGENT); }
        }
        pg8::Gemm g{HN, (const bf16_t*)(ws + (p == 1 ? WS_WGU1 : WS_WGU2)), NTOK, 2 * DFF, DM, DM, DM}; pg8::CountedOrder S; S.init(NTOK, 2 * DFF, G, bid); S.ready = cnt_; S.need = fuse_ ? 4u : 0u; S.wave = wave;
        EpiGU E{HFF};
        pg8::gemm_phase<EpiGU, pg8::CountedOrder, true, true>(ldsl, g, S, E, tid);
        if (p == 1 && G == 256 && bid >= 128) {
            const int lane2 = lane_id_volatile();
            convert_weights(ap, l, ws, (float*)lds + wave * (64 * 33), lane2, (bid - 128) * NWAVES + wave, 128 * NWAVES, (1u << 2) | (1u << 4) | (1u << 5) | (1u << 9));
        }
        break; }
    case 2: case 12: {
        PHASE_IDS;
        pg8::Gemm g{HFF, (const bf16_t*)(ws + (p == 2 ? WS_WD1 : WS_WD2)), NTOK, DM, DFF, DFF, DFF}; pg8::StaticOrder S; S.init(NTOK, DM, G, bid);
        EpiResid E{(l == 0 && p == 2 && rep == 0) ? args.in[0] : X, X, rep ? 0.f : 0.5f};
        pg8::gemm_phase<EpiResid, pg8::StaticOrder, true, true>(ldsl, g, S, E, tid);
        break; }
    case 3: case 10: {
        PHASE_IDS;
        const float* gain = (p == 3 ? args.in[5] : args.in[17]) + l * DM;
        for (int mrow = gw; mrow < NTOK; mrow += 4 * NGW) rms_rows4<false>(X, gain, HN, mrow, NGW, lane);
        break; }
    case 4: {
        PHASE_IDS;
        const bool fuse_ = (G == 256);
        unsigned* cnt_ = (unsigned*)(ws + WS_CNT) + (size_t)(l * 2 + 0) * 64 * 64;
        if (fuse_) {
            const float* gain = args.in[5] + l * DM; const int m0 = bid * 64 + wave * 8;
            rms_rows4<false, true>(X, gain, HN, m0, 1, lane); rms_rows4<false, true>(X, gain, HN, m0 + 4, 1, lane);
            asm volatile("s_waitcnt vmcnt(0)" ::: "memory"); __syncthreads();
            if (tid == 0) { (void)__hip_atomic_fetch_add(cnt_ + (bid >> 2) * 64, 1u, __ATOMIC_RELAXED, __HIP_MEMORY_SCOPE_AGENT); }
        }
        pg8::Gemm g{HN, (const bf16_t*)(ws + WS_WIN), NTOK, NWIN, DM, DM, DM}; pg8::CountedOrder S; S.init(NTOK, NWIN, G, bid); S.ready = cnt_; S.need = fuse_ ? 4u : 0u; S.wave = wave;
        EpiWin E{Q, KV, GN, U, GM};
        pg8::gemm_phase<EpiWin, pg8::CountedOrder, true, true>(ldsl, g, S, E, tid);
        if (G == 256 && bid >= 128) {
            const int lane2 = lane_id_volatile();
            convert_weights(ap, l, ws, (float*)lds + wave * (64 * 33), lane2, (bid - 128) * NWAVES + wave, 128 * NWAVES, (1u << 1) | (1u << 3) | (1u << 6) | (1u << 7) | (1u << 8));
        }
        break; }
    case 5: {
        PHASE_IDS;
        { pg8::Gemm g{KV, (const bf16_t*)(ws + WS_WC1), 4096, 512, 256, 1024, 2048}; CmpOrder S{G, bid}; EpiSplitK E{(float*)HN};
          pg8::gemm_phase<EpiSplitK, CmpOrder, true, true>(ldsl, g, S, E, tid); }
        const bf16_t* PWT = (const bf16_t*)(ws + WS_PW); const float* pscale = args.in[13] + l * 512;
        const int lane2 = lane_id_volatile();
        const int mr = lane2 & 15, kq = lane2 >> 4;
        const int gi = gw & 3, wq = gw >> 2, nwq = NGW >> 2;
        bf16x8 bw[8][4];
#pragma unroll
        for (int nn = 0; nn < 8; ++nn)
#pragma unroll
            for (int kk = 0; kk < 4; ++kk) bw[nn][kk] = ld8(PWT + (size_t)gi * 16384 + (16 * nn + mr) * 128 + kk * 32 + kq * 8);
        f32x4 scv[8];
#pragma unroll
        for (int nn = 0; nn < 8; ++nn) scv[nn] = *(const f32x4*)(pscale + gi * 128 + 16 * nn + 4 * kq);
        const bool deal_ = (G == 256);
        const int tt_first = deal_ ? (bid < 128 ? wq : wq) : wq, tt_step = deal_ ? 256 : nwq, tt_end = deal_ ? (bid < 128 ? 256 : 1024) : 1024;
        for (int tt = tt_first; tt < tt_end; tt += tt_step) {
            const int row = tt * 16 + mr, t = row & 8191;
            bf16x8 af[4];
            pool_delta(U, row, t, gi, kq, mr, af);
#pragma unroll
            for (int nn = 0; nn < 8; ++nn) {
                f32x4 acc = zero4();
#pragma unroll
                for (int kk = 0; kk < 4; ++kk) acc = __builtin_amdgcn_mfma_f32_16x16x32_bf16(bw[nn][kk], af[kk], acc, 0, 0, 0);
                const int c0 = gi * 128 + 16 * nn + 4 * kq;
                u32x2 o; o.x = pk2(acc[0] * scv[nn][0], acc[1] * scv[nn][1]); o.y = pk2(acc[2] * scv[nn][2], acc[3] * scv[nn][3]);
                *(u32x2*)(OPOOL + (size_t)row * 512 + c0) = o;
            }
        }
        break; }
    case 6: {
        PHASE_IDS;
        float* w2s = (float*)lds; float* hs = (float*)lds + 16384 + wave * 256;
        for (int rb = bid; rb < 256; rb += G) {
            const int kvs = rb >> 7; const float* w2 = (kvs ? args.in[11] : args.in[9]) + (size_t)l * 256 * 64;
            __syncthreads();
            for (int i = tid; i < 16384 / 4; i += NTHREADS) ((f32x4*)w2s)[i] = ((const f32x4*)w2)[i];
            __syncthreads();
            for (int rr = 0; rr < 2; ++rr) {
                const int rowi = rb * 16 + wave * 2 + rr, r2 = rowi & 2047, bg = r2 >> 9, n = r2 & 511;
                float outv = 0.f;
                if (n < 511) {
#pragma unroll
                    for (int i = 0; i < 4; ++i) { const int j = lane + 64 * i; float x = POSB[kvs * 256 + j]; { const float* pp = (const float*)HN + (size_t)rowi * 256 + j;
#pragma unroll
                        for (int kc = 0; kc < 8; ++kc) x += pp[(size_t)kc * (4096 * 256)]; }
                        const float y = 0.7978845608028654f * (x + 0.044715f * x * x * x); const float th = 1.f - 2.f / (1.f + __expf(2.f * y)); hs[j] = 0.5f * x * (1.f + th); }
                    __builtin_amdgcn_fence(__ATOMIC_RELEASE, "wavefront"); __builtin_amdgcn_wave_barrier();
                    for (int j = 0; j < 256; ++j) outv += hs[j] * w2s[j * 64 + lane];
                    __builtin_amdgcn_fence(__ATOMIC_RELEASE, "wavefront"); __builtin_amdgcn_wave_barrier();
                }
                if (kvs == 0) KCMP[((size_t)(bg * 8 + (n >> 6)) * 2 + (lane >> 5)) * 2048 + (n & 63) * 32 + (lane & 31)] = (bf16_t)f2bf(outv);
                else VCMPT[((size_t)(bg * 8 + (n >> 6)) * 2 + ((n & 63) >> 5)) * 2048 + lane * 32 + (n & 31)] = (bf16_t)f2bf(outv);
            }
        }
        break; }
    case 7: {
        PHASE_IDS;
        constexpr int NP = ATT_NP, NQ = 2 * NP;
        float* wl = (float*)lds + wave * (NQ * QS + NP * 4 * 64 * 4 + NP * 2 * 64 * 4);
        if ((G & 7) == 0) {
            const int xcd = bid & 7, bg = xcd >> 1, hx = xcd & 1, lw = (bid >> 3) * NWAVES + wave, nlw = (G >> 3) * NWAVES;
            for (int i = lw; i < T / NQ / 2; i += nlw) attn_item<NP>(bg, (2 * i + hx) * NQ, Q, KV, KCMP, VCMPT, GN, ONSA, wl, lane);
        } else {
            for (int qi = gw; qi < 4 * T / NQ; qi += NGW) attn_item<NP>((qi * NQ) >> 13, (qi * NQ) & 8191, Q, KV, KCMP, VCMPT, GN, ONSA, wl, lane);
        }
        break; }
    case 8: {
        PHASE_IDS;
        { pg8::Gemm g{OPOOL, (const bf16_t*)(ws + WS_WBP), NTOK, DM, 512, 512, 512}; pg8::StaticOrder S; S.init(NTOK, DM, G, bid); EpiMerge<0> E{MG, GM};
          pg8::gemm_phase<EpiMerge<0>, pg8::StaticOrder, true, true>(ldsl, g, S, E, tid); }
        __syncthreads();
        { pg8::Gemm g{ONSA, (const bf16_t*)(ws + WS_WBN), NTOK, DM, DM, DM, DM}; pg8::StaticOrder S; S.init(NTOK, DM, G, bid); EpiMerge<1> E{MG, GM};
          pg8::gemm_phase<EpiMerge<1>, pg8::StaticOrder, true, true>(ldsl, g, S, E, tid); }
        break; }
    case 9: {
        PHASE_IDS;
        pg8::Gemm g{MG, (const bf16_t*)(ws + WS_WO), NTOK, DM, DM, DM, DM}; pg8::StaticOrder S; S.init(NTOK, DM, G, bid);
        EpiResid E{X, X, rep ? 0.f : 1.0f};
        pg8::gemm_phase<EpiResid, pg8::StaticOrder, true, true>(ldsl, g, S, E, tid);
        break; }
    default: break;
    }
}

__global__ void __launch_bounds__(NTHREADS, 2) fwd_kernel(Args args) {
    extern __shared__ __attribute__((aligned(16))) unsigned char lds[];
    cg::grid_group grid = cg::this_grid();
    const int ph_lo = args.ph_lo, ph_hi = args.ph_hi;
    volatile LAS unsigned* bst = (volatile LAS unsigned*)((LAS unsigned char*)lds + (LDS_BYTES - 64));
    const int wave_s = __builtin_amdgcn_readfirstlane((int)threadIdx.x >> 6);
    if (threadIdx.x == 0) { bst[0] = 0u; bst[1] = 0u; }
    __syncthreads();
    (void)xcd_barrier_post((unsigned*)(args.ws + WS_BAR), bst);
    if (ph_hi < 0) grid.sync();
    for (int ph = ph_lo; ph < ph_hi; ++ph) {
        if (gridDim.x == 256 && (ph % NPH_LAYER == 3 || ph % NPH_LAYER == 10) && ph < 2 * NPH_LAYER) continue;
        ArgsP ap = (ArgsP)__builtin_amdgcn_kernarg_segment_ptr(); asm volatile("" : "+s"(ap));
        { const int pp = ph % NPH_LAYER; const int reps = (((PROBE_MASK >> pp) & 1) && ph < 2 * NPH_LAYER) ? 2 : 1; for (int r = 0; r < reps; ++r) { if (r) __syncthreads(); run_phase(ap, ph, lds, r, wave_s); } }
        if (ph + 1 < ph_hi) for (int sr = 0; sr < SYNC_REPS; ++sr) {
            XcdBarrier xb2; xb2.bar = (unsigned*)(ap->ws + WS_BAR); xb2.x = xb_xcc_id(); xb2.st = (volatile LAS unsigned*)((LAS unsigned char*)lds + (LDS_BYTES - 64));
            xcd_barrier(xb2, wave_s * 64 + lane_id_volatile()); }
    }
}

#ifndef N_LAUNCH_MODE
#define N_LAUNCH_MODE 0
#endif

extern "C" void kernel_launch(void* const* d_in, const int* in_sizes, int n_in, void* d_out, int out_size, void* d_ws, size_t ws_size, hipStream_t stream) {
    static int grid = 0;
    if (grid == 0) {
        int dev = 0, cus = 0, per_cu = 0;
        (void)hipGetDevice(&dev);
        (void)hipDeviceGetAttribute(&cus, hipDeviceAttributeMultiprocessorCount, dev);
        (void)hipFuncSetAttribute((const void*)fwd_kernel, hipFuncAttributeMaxDynamicSharedMemorySize, LDS_BYTES);
        (void)hipOccupancyMaxActiveBlocksPerMultiprocessor(&per_cu, (const void*)fwd_kernel, NTHREADS, LDS_BYTES);
        if (per_cu < 1) per_cu = 1;
        grid = cus * per_cu;
        if (grid > 256) grid = 256;
        (void)hipGetLastError();
    }
    (void)hipMemsetAsync((char*)d_ws + WS_BAR, 0, 16384 + 4 * 64 * 256, stream);
    Args a{};
    for (int i = 0; i < 22; ++i) a.in[i] = (const float*)d_in[i];
    a.out = (float*)d_out; a.ws = (unsigned char*)d_ws;
#if N_LAUNCH_MODE == 0
    a.ph_lo = 0; a.ph_hi = NPHASES;
    void* kargs[] = {&a};
    hipError_t e = hipLaunchCooperativeKernel((const void*)fwd_kernel, dim3(grid), dim3(NTHREADS), kargs, LDS_BYTES, stream);
    if (e != hipSuccess) fprintf(stderr, "cooperative launch failed: %s (grid %d)\n", hipGetErrorString(e), grid);
#else
    for (int ph = 0; ph < NPHASES; ++ph) {
        a.ph_lo = ph; a.ph_hi = ph + 1;
        hipLaunchKernelGGL(fwd_kernel, dim3(grid), dim3(NTHREADS), LDS_BYTES, stream, a);
    }
#endif
}
```
